# Optimizing an MI355X kernel written in HIP

```python
import math
import jax, jax.numpy as jnp
from jax import lax
import numpy as np

D_MODEL = 1024
BATCH = 8
SEQ = 2048
DEPTH = 1
DEC_BATCH = 128
DEC_SEQ = 8
PAST_LEN = 16384
PAGE_SIZE = 128

D_INNER = D_MODEL
HEAD_DIM = 64
N_HEADS = D_INNER // HEAD_DIM
N_GROUPS = 2
HEADS_PER_GROUP = N_HEADS // N_GROUPS
D_STATE = 128
CONV_WIDTH = 4
CONV_DIM = D_INNER + 2 * N_GROUPS * D_STATE
SSD_CHUNK = 128
D_POOL = D_MODEL // 2
POOL_WINDOWS = (2, 4, 8, 16)
N_POOL_GROUPS = len(POOL_WINDOWS)
POOL_GROUP = D_POOL // N_POOL_GROUPS
POOL_HIST = max(POOL_WINDOWS) - 1
N_BRANCHES = 2
EPS = 1e-6
IN_SPLITS = (D_INNER, CONV_DIM, N_HEADS, D_POOL, D_POOL, N_BRANCHES * D_MODEL)
D_IN_PROJ = sum(IN_SPLITS)
IN_OFFSETS = tuple(int(v) for v in np.cumsum(IN_SPLITS)[:-1])

kernel_name = 'hybrid_ssd_pool_gated_decoder_step'

F32 = jnp.float32


def _rmsnorm(x, g):
    xf = x.astype(F32)
    xf = xf * lax.rsqrt(jnp.mean(xf * xf, axis=-1, keepdims=True) + EPS)
    return (xf * g.astype(F32)).astype(x.dtype)


def _causal_conv(xbc, buf, conv_w, conv_b):
    L = xbc.shape[1]
    ext = jnp.concatenate([buf.astype(xbc.dtype), xbc], axis=1)
    extf = ext.astype(F32)
    w = conv_w.astype(F32)
    out = conv_b.astype(F32)
    for k in range(CONV_WIDTH):
        out = out + extf[:, k:k + L] * w[k]
    return jax.nn.silu(out), ext[:, -(CONV_WIDTH - 1):]


def _ssd(x, dt, a, b_in, c_in, h0):
    bsz, l = x.shape[0], x.shape[1]
    q = math.gcd(l, SSD_CHUNK)
    nc = l // q
    xr = (x * dt[..., None]).reshape(bsz, nc, q, N_GROUPS, HEADS_PER_GROUP, HEAD_DIM)
    adt = (dt * a).reshape(bsz, nc, q, N_GROUPS, HEADS_PER_GROUP)
    acum = jnp.cumsum(adt, axis=2)
    bc = b_in.reshape(bsz, nc, q, N_GROUPS, D_STATE)
    cc = c_in.reshape(bsz, nc, q, N_GROUPS, D_STATE)
    causal = jnp.tril(jnp.ones((q, q), dtype=bool))[None, None, :, :, None, None]
    seg = acum[:, :, :, None] - acum[:, :, None, :]
    decay = jnp.exp(jnp.where(causal, seg, -jnp.inf))
    cb = jnp.einsum('bclgn,bcsgn->bclsg', cc, bc)
    y_diag = jnp.einsum('bclsg,bclsgr,bcsgrp->bclgrp', cb, decay, xr)
    decay_to_end = jnp.exp(acum[:, :, -1:] - acum)
    chunk_states = jnp.einsum('bcsgn,bcsgr,bcsgrp->bcgrpn', bc, decay_to_end, xr)
    chunk_decay = jnp.exp(acum[:, :, -1])

    def step(h, inp):
        st, dec = inp
        return h * dec[..., None, None] + st, h

    h0r = h0.reshape(bsz, N_GROUPS, HEADS_PER_GROUP, HEAD_DIM, D_STATE)
    h_final, h_in = lax.scan(step, h0r, (jnp.moveaxis(chunk_states, 1, 0), jnp.moveaxis(chunk_decay, 1, 0)))
    h_in = jnp.moveaxis(h_in, 0, 1)
    y_off = jnp.einsum('bclgn,bcgrpn,bclgr->bclgrp', cc, h_in, jnp.exp(acum))
    y = (y_diag + y_off).reshape(bsz, l, N_HEADS, HEAD_DIM)
    return y, h_final.reshape(bsz, N_HEADS, HEAD_DIM, D_STATE)


def _mamba_branch(z, xbc, dt_raw, conv_buf, ssm_state, conv_w, conv_b, dt_bias, a_log, d_skip, ssm_norm):
    bsz, L, _ = z.shape
    xbc_act, new_conv = _causal_conv(xbc, conv_buf, conv_w, conv_b)
    xs = xbc_act[..., :D_INNER].reshape(bsz, L, N_HEADS, HEAD_DIM)
    bm = xbc_act[..., D_INNER:D_INNER + N_GROUPS * D_STATE].reshape(bsz, L, N_GROUPS, D_STATE)
    cm = xbc_act[..., D_INNER + N_GROUPS * D_STATE:].reshape(bsz, L, N_GROUPS, D_STATE)
    dt = jax.nn.softplus(dt_raw.astype(F32) + dt_bias.astype(F32))
    a = -jnp.exp(a_log.astype(F32))
    y, new_ssm = _ssd(xs, dt, a, bm, cm, ssm_state.astype(F32))
    y = y + d_skip.astype(F32)[:, None] * xs
    y = y.reshape(bsz, L, D_INNER) * jax.nn.silu(z.astype(F32))
    yg = y.reshape(bsz, L, N_GROUPS, D_INNER // N_GROUPS)
    yg = yg * lax.rsqrt(jnp.mean(yg * yg, axis=-1, keepdims=True) + EPS)
    y = yg.reshape(bsz, L, D_INNER) * ssm_norm.astype(F32)
    return y, new_conv, new_ssm


def _pool_branch(u, g, buf, pos0, pool_mix, pool_scale):
    bsz, L, _ = u.shape
    ext = jnp.concatenate([buf.astype(u.dtype), u], axis=1)
    extf = ext.astype(F32)
    csum = jnp.concatenate([jnp.zeros((bsz, 1, D_POOL), F32), jnp.cumsum(extf, axis=1)], axis=1)
    hi = csum[:, POOL_HIST + 1:]
    pos = jnp.arange(L, dtype=jnp.int32) + pos0
    means = []
    for k, w in enumerate(POOL_WINDOWS):
        sl = slice(k * POOL_GROUP, (k + 1) * POOL_GROUP)
        lo = csum[:, POOL_HIST + 1 - w:POOL_HIST + 1 - w + L, sl]
        cnt = jnp.minimum(pos + 1, w).astype(F32)
        means.append((hi[..., sl] - lo) / cnt[None, :, None])
    tok = extf[:, POOL_HIST:].reshape(bsz, L, N_POOL_GROUPS, POOL_GROUP)
    pooled = jnp.stack(means, axis=2) - tok
    mixed = jnp.einsum('blkc,kcd->blkd', pooled, pool_mix.astype(F32)).reshape(bsz, L, D_POOL)
    out = mixed * pool_scale.astype(F32) * jax.nn.silu(g.astype(F32))
    return out, ext[:, -POOL_HIST:]


def _layer(x, conv_buf, ssm_state, pool_buf, pos0, norm_pre, w_in, conv_w, conv_b, dt_bias, a_log,
           d_skip, ssm_norm, w_branch_a, pool_mix, pool_scale, w_branch_b, w_out, norm_post):
    h = _rmsnorm(x, norm_pre)
    proj = jnp.einsum('bld,de->ble', h, w_in)
    z, xbc, dt_raw, u, g, gates = jnp.split(proj, IN_OFFSETS, axis=-1)
    ya, new_conv, new_ssm = _mamba_branch(z, xbc, dt_raw, conv_buf, ssm_state, conv_w, conv_b,
                                          dt_bias, a_log, d_skip, ssm_norm)
    yb, new_pool = _pool_branch(u, g, pool_buf, pos0, pool_mix, pool_scale)
    pa = jnp.einsum('ble,ed->bld', ya.astype(x.dtype), w_branch_a)
    pb = jnp.einsum('ble,ed->bld', yb.astype(x.dtype), w_branch_b)
    gate_a, gate_b = jnp.split(gates, N_BRANCHES, axis=-1)
    merged = jax.nn.sigmoid(gate_a) * pa + jax.nn.sigmoid(gate_b) * pb
    out = jnp.einsum('bld,de->ble', merged, w_out)
    y = x + _rmsnorm(out, norm_post)
    return y, new_conv, new_ssm.astype(x.dtype), new_pool


def setup_inputs(seed: int = 0) -> dict:
    key = jax.random.key(seed)
    ks = jax.random.split(key, 24)
    nrm = lambda k, shp, s: s * jax.random.normal(k, shp, F32)
    dt0 = jnp.exp(jax.random.uniform(ks[9], (DEPTH, N_HEADS), F32, math.log(1e-3), math.log(1e-1)))
    return {
        'x_prompt': nrm(ks[0], (BATCH, SEQ, D_MODEL), 1.0),
        'x_sample': nrm(ks[1], (DEC_BATCH, DEC_SEQ, D_MODEL), 1.0),
        'state_conv': nrm(ks[2], (DEPTH, DEC_BATCH, CONV_WIDTH - 1, CONV_DIM), 1.0),
        'state_ssm': nrm(ks[3], (DEPTH, DEC_BATCH, N_HEADS, HEAD_DIM, D_STATE), 0.1),
        'state_pool': nrm(ks[4], (DEPTH, DEC_BATCH, POOL_HIST, D_POOL), 1.0),
        'norm_pre': 1.0 + nrm(ks[5], (DEPTH, D_MODEL), 0.02),
        'w_in': nrm(ks[6], (DEPTH, D_MODEL, D_IN_PROJ), D_MODEL ** -0.5),
        'conv_w': nrm(ks[7], (DEPTH, CONV_WIDTH, CONV_DIM), CONV_WIDTH ** -0.5),
        'conv_b': nrm(ks[8], (DEPTH, CONV_DIM), 0.02),
        'dt_bias': dt0 + jnp.log(-jnp.expm1(-dt0)),
        'a_log': jnp.log(jax.random.uniform(ks[10], (DEPTH, N_HEADS), F32, 1.0, 16.0)),
        'd_skip': 1.0 + nrm(ks[11], (DEPTH, N_HEADS), 0.02),
        'ssm_norm': 1.0 + nrm(ks[12], (DEPTH, D_INNER), 0.02),
        'w_branch_a': nrm(ks[13], (DEPTH, D_INNER, D_MODEL), D_INNER ** -0.5),
        'pool_mix': nrm(ks[14], (DEPTH, N_POOL_GROUPS, POOL_GROUP, POOL_GROUP), POOL_GROUP ** -0.5),
        'pool_scale': 1.0 + nrm(ks[15], (DEPTH, D_POOL), 0.02),
        'w_branch_b': nrm(ks[16], (DEPTH, D_POOL, D_MODEL), D_POOL ** -0.5),
        'w_out': nrm(ks[17], (DEPTH, D_MODEL, D_MODEL), D_MODEL ** -0.5),
        'norm_post': 1.0 + nrm(ks[18], (DEPTH, D_MODEL), 0.02),
    }


def reference(x_prompt, x_sample, state_conv, state_ssm, state_pool, norm_pre, w_in, conv_w, conv_b,
              dt_bias, a_log, d_skip, ssm_norm, w_branch_a, pool_mix, pool_scale, w_branch_b, w_out,
              norm_post):
    yp, ys = x_prompt, x_sample
    conv_p, ssm_p, pool_p, conv_s, ssm_s, pool_s = [], [], [], [], [], []
    for i in range(DEPTH):
        params = (norm_pre[i], w_in[i], conv_w[i], conv_b[i], dt_bias[i], a_log[i], d_skip[i], ssm_norm[i],
                  w_branch_a[i], pool_mix[i], pool_scale[i], w_branch_b[i], w_out[i], norm_post[i])
        dt_ = x_prompt.dtype
        zc = jnp.zeros((BATCH, CONV_WIDTH - 1, CONV_DIM), dt_)
        zs = jnp.zeros((BATCH, N_HEADS, HEAD_DIM, D_STATE), dt_)
        zq = jnp.zeros((BATCH, POOL_HIST, D_POOL), dt_)
        yp, c1, s1, q1 = _layer(yp, zc, zs, zq, 0, *params)
        ys, c2, s2, q2 = _layer(ys, state_conv[i], state_ssm[i], state_pool[i], PAST_LEN, *params)
        conv_p.append(c1); ssm_p.append(s1); pool_p.append(q1)
        conv_s.append(c2); ssm_s.append(s2); pool_s.append(q2)
    return (yp, ys, jnp.stack(conv_p), jnp.stack(ssm_p), jnp.stack(pool_p),
            jnp.stack(conv_s), jnp.stack(ssm_s), jnp.stack(pool_s))
```

```cpp
#include <hip/hip_runtime.h>
#include <hip/hip_cooperative_groups.h>
#include <cstdio>
#include <cstdint>
namespace cg = cooperative_groups;

#define LAS __attribute__((address_space(3)))
typedef unsigned short bf16_t;
typedef short bf16x8 __attribute__((ext_vector_type(8)));
typedef float f32x4 __attribute__((ext_vector_type(4)));
typedef float f32x2 __attribute__((ext_vector_type(2)));
typedef unsigned u32x4 __attribute__((ext_vector_type(4)));
typedef unsigned u32x2 __attribute__((ext_vector_type(2)));

constexpr int DM = 1024, SEQ = 2048, NB_P = 8, NB_S = 128, LS = 8;
constexpr int NTOK_P = NB_P * SEQ, NTOK_S = NB_S * LS, MTOK = NTOK_P + NTOK_S;
constexpr int NPROJ = 5632;
constexpr int C_Z = 0, C_XBC = 1024, C_U = 2560, C_G = 3072, C_GATE = 3584;
constexpr int DIN = 5648, CONVD = 1536, NH = 16, HD = 64, DS = 128, DPOOL = 512, KCAT = 1536;
constexpr float EPS = 1e-6f;

constexpr size_t WS_CTL = 0;
constexpr size_t WS_SSQ = 4096;
constexpr size_t WS_SSQ2 = WS_SSQ + (size_t)MTOK * 2 * 4;
constexpr size_t WS_DT = WS_SSQ2 + (size_t)MTOK * 4;
constexpr size_t WS_WIN = (WS_DT + (size_t)MTOK * 16 * 4 + 255) / 256 * 256;
constexpr size_t WS_WCAT = WS_WIN + (size_t)NPROJ * DM * 2;
constexpr size_t WS_WOUT = WS_WCAT + (size_t)DM * KCAT * 2;
constexpr size_t WS_PMIX = WS_WOUT + (size_t)DM * DM * 2;
constexpr size_t WS_MERGED = WS_PMIX + (size_t)4 * 128 * 128 * 2;
constexpr size_t WS_PROJ = WS_MERGED + (size_t)MTOK * DM * 2;
constexpr size_t WS_END = WS_PROJ + (size_t)MTOK * NPROJ * 2;

constexpr size_t O_YP = 0, O_YS = O_YP + (size_t)NTOK_P * DM, O_CONVP = O_YS + (size_t)NTOK_S * DM, O_SSMP = O_CONVP + (size_t)NB_P * 3 * CONVD,
                 O_POOLP = O_SSMP + (size_t)NB_P * NH * HD * DS, O_CONVS = O_POOLP + (size_t)NB_P * 15 * DPOOL, O_SSMS = O_CONVS + (size_t)NB_S * 3 * CONVD,
                 O_POOLS = O_SSMS + (size_t)NB_S * NH * HD * DS, O_END = O_POOLS + (size_t)NB_S * 15 * DPOOL;

constexpr int LDS_BYTES = 147456;

struct Params {
    const float *x_p, *x_s, *st_conv, *st_ssm, *st_pool, *norm_pre, *w_in, *conv_w, *conv_b, *dt_bias, *a_log, *d_skip, *ssm_norm, *w_a, *pool_mix, *pool_scale, *w_b, *w_out, *norm_post;
    float* out; unsigned char* ws; int ph_lo, ph_hi;
};

__device__ __forceinline__ unsigned cvt_pk_bf16(float lo, float hi) { unsigned r; asm("v_cvt_pk_bf16_f32 %0, %1, %2" : "=v"(r) : "v"(lo), "v"(hi)); return r; }
__device__ __forceinline__ float bf_lo(unsigned u) { return __uint_as_float(u << 16); }
__device__ __forceinline__ float bf_hi(unsigned u) { return __uint_as_float(u & 0xffff0000u); }
__device__ __forceinline__ float bf2f(bf16_t v) { return __uint_as_float((unsigned)v << 16); }
__device__ __forceinline__ float silu_f(float v) { return v / (1.f + __expf(-v)); }
__device__ __forceinline__ float wave_sum(float v) {
#pragma unroll
    for (int o = 1; o < 64; o <<= 1) v += __shfl_xor(v, o);
    return v;
}
#define LDS_WAIT() asm volatile("s_waitcnt lgkmcnt(0)" ::: "memory")
#define MFMA16(a, b, c) __builtin_amdgcn_mfma_f32_16x16x32_bf16((a), (b), (c), 0, 0, 0)

namespace pg8 {
#define PG8_LAS __attribute__((address_space(3)))
typedef unsigned short bf16_t;
typedef short bf16x8 __attribute__((ext_vector_type(8)));
typedef float f32x4 __attribute__((ext_vector_type(4)));
typedef unsigned u32x4 __attribute__((ext_vector_type(4)));
constexpr int BM = 256, BK = 64, HALF = 128, HTB = HALF * BK * 2  , STAGE_BYTES = 8 * HTB, NXCD = 8, WGM = 8;

__host__ __device__ __forceinline__ int lds_byte(int r, int c) { const int st = (r >> 4) * 2 + (c >> 5), rr = r & 15, cc = c & 31, ob = rr * 64 + cc * 2; return st * 1024 + (ob ^ (((ob >> 9) & 1) << 5)); }
__host__ __device__ __forceinline__ void stage_rc(int b, int& R, int& C) { const int st = b / 1024, sb = b % 1024, swz = sb ^ (((sb >> 9) & 1) << 5); R = (st >> 1) * 16 + swz / 64; C = (st & 1) * 32 + (swz % 64) / 2; }
__host__ __device__ __forceinline__ int perm32(int rho) { const int n = rho >> 4, i = rho & 15; return 8 * (i >> 2) + 4 * n + (i & 3); }

struct Unit { int pm, pn, seg; };
struct Gemm { const bf16_t* A; const bf16_t* Bt; int M, N, K; };

struct StaticOrder {
    int nM, nN, nwg, G, c;
    __host__ __device__ void init(int M, int N, int G_, int c_) { nM = M / BM; nN = N / BM; nwg = nM * nN; G = G_; c = c_; }
    __host__ __device__ bool next(int i, Unit& u) const {
        const long L = (long)i * G + c; if (L >= nwg) return false;
        int wgid = (int)L; { const int q = nwg / NXCD, r = nwg % NXCD, xcd = wgid % NXCD, off = wgid / NXCD; wgid = (xcd < r ? xcd * (q + 1) : r * (q + 1) + (xcd - r) * q) + off; }
        const int nig = WGM * nN, gid = wgid / nig, fm = gid * WGM, gsz = (nM - fm) < WGM ? (nM - fm) : WGM;
        u.pm = fm + ((wgid % nig) % gsz); u.pn = (wgid % nig) / gsz; u.seg = 0; return true;
    }
    __device__ __forceinline__ void a_ready(const Unit&) const {}
    __device__ __forceinline__ void done(const Unit&) const {}
};

struct SegOrder : StaticOrder {
    __host__ __device__ bool next(int i, Unit& u) const { const bool ok = StaticOrder::next(i / 3, u); u.seg = i % 3; return ok; }
};

struct EpiStore {
    static constexpr bool PERM = true, AFTER_DRAIN = false, HOOKS = false;
    bf16_t* O; int ldc;
    __device__ __forceinline__ void operator()(const f32x4 (&acc)[2][2][4][2], const Unit& u, int wr, int wc, int fr, int fq) const {
        const int row0 = u.pm * BM + wr * 64 + fr, col0 = u.pn * BM + wc * 32 + 8 * fq;
#pragma unroll
        for (int ai = 0; ai < 2; ++ai)
#pragma unroll
            for (int m = 0; m < 4; ++m) { bf16_t* rowp = O + (size_t)(row0 + ai * HALF + m * 16) * ldc + col0;
#pragma unroll
                for (int bj = 0; bj < 2; ++bj) { const f32x4 v0 = acc[ai][bj][m][0], v1 = acc[ai][bj][m][1];
                    u32x4 w; w.x = ::cvt_pk_bf16(v0[0], v0[1]); w.y = ::cvt_pk_bf16(v0[2], v0[3]); w.z = ::cvt_pk_bf16(v1[0], v1[1]); w.w = ::cvt_pk_bf16(v1[2], v1[3]);
                    *(u32x4*)(rowp + bj * HALF) = w; } }
    }
};
struct EpiMerge {
    static constexpr bool PERM = true, AFTER_DRAIN = false, HOOKS = true;
    const bf16_t* proj; const float* ssq; bf16_t* O;
    __device__ __forceinline__ void operator()(f32x4 (&acc)[2][2][4][2], const Unit& u, int wr, int wc, int fr, int fq) const {
        int row0 = u.pm * BM + wr * 64 + fr, col0 = u.pn * BM + wc * 32 + 8 * fq;
        asm volatile("" : "+v"(row0), "+v"(col0));
        const char* pb = (const char*)proj; const int seg = u.seg;
#pragma unroll
        for (int ai = 0; ai < 2; ++ai)
#pragma unroll
            for (int m = 0; m < 4; ++m) { const int row = row0 + ai * HALF + m * 16; const ::f32x2 s = *(const ::f32x2*)((const char*)ssq + (unsigned)row * 8u);
                const float q1 = s.y * (1.f / 512.f) + ::EPS, r1 = rsqrtf(q1), rr = rsqrtf(s.x * (1.f / 512.f) + ::EPS) * __builtin_amdgcn_sqrtf(q1);
                const unsigned goff = ((unsigned)row * (unsigned)::NPROJ + (unsigned)(::C_GATE + col0)) * 2u, ooff = ((unsigned)row * (unsigned)::DM + (unsigned)col0) * 2u;
#pragma unroll
                for (int bj = 0; bj < 2; ++bj) { const u32x4 ga = *(const u32x4*)(pb + goff + bj * 256), gb = *(const u32x4*)(pb + goff + 2048 + bj * 256); float v[8];
#pragma unroll
                    for (int idx = 0; idx < 8; ++idx) { const unsigned wa = ga[idx >> 1], wb = gb[idx >> 1];
                        const float va = (idx & 1) ? ::bf_hi(wa) : ::bf_lo(wa), vb = (idx & 1) ? ::bf_hi(wb) : ::bf_lo(wb);
                        const float ea = 1.f + __expf(-va), eb = 1.f + __expf(-vb);
                        const float f = seg == 0 ? rr : (seg == 1 ? r1 * eb * __builtin_amdgcn_rcpf(ea) : __builtin_amdgcn_rcpf(eb));
                        v[idx] = acc[ai][bj][m][idx >> 2][idx & 3] * f; }
                    if (seg == 2) { u32x4 w; w.x = ::cvt_pk_bf16(v[0], v[1]); w.y = ::cvt_pk_bf16(v[2], v[3]); w.z = ::cvt_pk_bf16(v[4], v[5]); w.w = ::cvt_pk_bf16(v[6], v[7]);
                        *(u32x4*)((char*)O + ooff + bj * 256) = w; }
                    const float keep = seg == 2 ? 0.f : 1.f;
                    acc[ai][bj][m][0] = (f32x4){v[0], v[1], v[2], v[3]} * keep; acc[ai][bj][m][1] = (f32x4){v[4], v[5], v[6], v[7]} * keep;
                    asm volatile("" : "+v"(acc[ai][bj][m][0]), "+v"(acc[ai][bj][m][1]) :: "memory"); } }
    }
};
struct EpiOut {
    static constexpr bool PERM = true, AFTER_DRAIN = false, HOOKS = false;
    bf16_t* O; float* ssq2;
    __device__ __forceinline__ void operator()(const f32x4 (&acc)[2][2][4][2], const Unit& u, int wr, int wc, int fr, int fq) const {
        const int row0 = u.pm * BM + wr * 64 + fr, col0 = u.pn * BM + wc * 32 + 8 * fq;
#pragma unroll
        for (int ai = 0; ai < 2; ++ai)
#pragma unroll
            for (int m = 0; m < 4; ++m) { const int row = row0 + ai * HALF + m * 16; float ss = 0.f;
#pragma unroll
                for (int bj = 0; bj < 2; ++bj) { const f32x4 v0 = acc[ai][bj][m][0], v1 = acc[ai][bj][m][1];
                    ss += (v0[0] * v0[0] + v0[1] * v0[1]) + (v0[2] * v0[2] + v0[3] * v0[3]) + (v1[0] * v1[0] + v1[1] * v1[1]) + (v1[2] * v1[2] + v1[3] * v1[3]);
                    u32x4 w; w.x = ::cvt_pk_bf16(v0[0], v0[1]); w.y = ::cvt_pk_bf16(v0[2], v0[3]); w.z = ::cvt_pk_bf16(v1[0], v1[1]); w.w = ::cvt_pk_bf16(v1[2], v1[3]);
                    *(u32x4*)(O + (size_t)row * ::DM + col0 + bj * HALF) = w; }
                ss += __shfl_xor(ss, 16); ss += __shfl_xor(ss, 32);
                if (fq == 0) atomicAdd(ssq2 + row, ss); }
    }
};

template <class Epi, class Sched>
__device__ __forceinline__ void gemm_phase(PG8_LAS unsigned char* lds, const Gemm g, const Sched& S, const Epi& E) {
    const int tid = threadIdx.x, wid = __builtin_amdgcn_readfirstlane(tid >> 6), lane = tid & 63, wr = wid >> 2, wc = wid & 3, fr = lane & 15, fq = lane >> 4;
    const int K = g.K, nt = Epi::HOOKS ? 8 : K / BK;
    unsigned voffA[2], voffB[2];
#pragma unroll
    for (int i = 0; i < 2; ++i) { int R, C; stage_rc(tid * 16 + i * 8192, R, C); const int Rb = Epi::PERM ? ((R & ~31) + perm32(R & 31)) : R;
        voffA[i] = (unsigned)(R * K + C) * 2u; voffB[i] = (unsigned)(Rb * K + C) * 2u; }
    const size_t kstep = (size_t)(BK * 2);
    const size_t hstep = (size_t)HALF * K * 2;
    const size_t tstep = 2 * hstep;
    const unsigned ldsw = (unsigned)wid * 1024u;
    const int aoff = lds_byte(wr * 64 + fr, fq * 8), boff = lds_byte(wc * 32 + fr, fq * 8);
#define PG8_SA(b, h) (((b) * 2 + (h)) * HTB)
#define PG8_SB(b, h) ((4 + (b) * 2 + (h)) * HTB)
#define PG8_STAGE(bufoff, gbase, voff) do { _Pragma("unroll") for (int _i = 0; _i < 2; ++_i) \
        __builtin_amdgcn_global_load_lds((const unsigned*)((const char*)(gbase) + (voff)[_i]), (PG8_LAS unsigned*)(lds + (bufoff) + ldsw + _i * 8192), 16, 0, 0); } while (0)
#define PG8_LDA(dst, b, h) do { _Pragma("unroll") for (int m = 0; m < 4; ++m) _Pragma("unroll") for (int k = 0; k < 2; ++k) dst[m][k] = *(const PG8_LAS bf16x8*)(lds + PG8_SA(b, h) + aoff + m * 2048 + k * 1024); } while (0)
#define PG8_LDB(dst, b, h) do { _Pragma("unroll") for (int n = 0; n < 2; ++n) _Pragma("unroll") for (int k = 0; k < 2; ++k) dst[n][k] = *(const PG8_LAS bf16x8*)(lds + PG8_SB(b, h) + boff + n * 2048 + k * 1024); } while (0)
#define PG8_MMA(ai, bj, At, Bt) do { __builtin_amdgcn_s_setprio(1); _Pragma("unroll") for (int m = 0; m < 4; ++m) _Pragma("unroll") for (int n = 0; n < 2; ++n) _Pragma("unroll") for (int k = 0; k < 2; ++k) \
        acc[ai][bj][m][n] = __builtin_amdgcn_mfma_f32_16x16x32_bf16(Bt[n][k], At[m][k], acc[ai][bj][m][n], 0, 0, 0); __builtin_amdgcn_s_setprio(0); } while (0)
#define PG8_WAIT_V(n) asm volatile("s_waitcnt vmcnt(" #n ")" ::: "memory")
#define PG8_WAIT_L(n) asm volatile("s_waitcnt lgkmcnt(" #n ")" ::: "memory")
#define PG8_BAR __builtin_amdgcn_s_barrier()
#define PG8_SCHED __builtin_amdgcn_sched_barrier(0)
    Unit cur, nxt; int ui = 0;
    if (!S.next(0, cur)) return;
    f32x4 acc[2][2][4][2];
#pragma unroll
    for (int a = 0; a < 2; ++a)
#pragma unroll
        for (int b = 0; b < 2; ++b)
#pragma unroll
            for (int m = 0; m < 4; ++m)
#pragma unroll
                for (int n = 0; n < 2; ++n) acc[a][b][m][n] = (f32x4){0.f, 0.f, 0.f, 0.f};
    bf16x8 At[4][2], B0[2][2], B1[2][2];
    const char* cA = (const char*)g.A + (size_t)cur.pm * tstep + (Epi::HOOKS ? cur.seg * 1024 : 0); const char* cB = (const char*)g.Bt + (size_t)cur.pn * tstep + (Epi::HOOKS ? cur.seg * 1024 : 0);
    S.a_ready(cur);
    PG8_STAGE(PG8_SB(0, 0), cB, voffB); PG8_STAGE(PG8_SA(0, 0), cA, voffA); PG8_STAGE(PG8_SB(0, 1), cB + hstep, voffB); PG8_STAGE(PG8_SA(0, 1), cA + hstep, voffA);
    if (wr == 1) PG8_BAR;
    PG8_WAIT_V(4); PG8_BAR;
    PG8_STAGE(PG8_SB(1, 0), cB + kstep, voffB); PG8_STAGE(PG8_SA(1, 0), cA + kstep, voffA); PG8_STAGE(PG8_SB(1, 1), cB + hstep + kstep, voffB);
    PG8_WAIT_V(6); PG8_BAR;
    for (;;) {
        const bool has_next = S.next(ui + 1, nxt);
        const char* nA = has_next ? (const char*)g.A + (size_t)nxt.pm * tstep + (Epi::HOOKS ? nxt.seg * 1024 : 0) : cA; const char* nB = has_next ? (const char*)g.Bt + (size_t)nxt.pn * tstep + (Epi::HOOKS ? nxt.seg * 1024 : 0) : cB;
        for (int t = 0; t < nt; t += 2) {
            const bool last = (t == nt - 2);
            const char* a1 = cA + (size_t)(t + 1) * kstep;
            const char* a2 = last ? nA : cA + (size_t)(t + 2) * kstep; const char* b2 = last ? nB : cB + (size_t)(t + 2) * kstep;
            const char* a3 = a2 + kstep; const char* b3 = b2 + kstep;
            if (last && has_next) S.a_ready(nxt);
            PG8_LDB(B0, 0, 0); PG8_SCHED; PG8_LDA(At, 0, 0); PG8_STAGE(PG8_SA(1, 1), a1 + hstep, voffA);
            PG8_WAIT_L(8); PG8_BAR; PG8_WAIT_L(0); PG8_MMA(0, 0, At, B0); PG8_BAR; PG8_SCHED;
            PG8_LDB(B1, 0, 1); PG8_STAGE(PG8_SB(0, 0), b2, voffB);
            PG8_BAR; PG8_WAIT_L(0); PG8_MMA(0, 1, At, B1); PG8_BAR;
            PG8_LDA(At, 0, 1); PG8_STAGE(PG8_SA(0, 0), a2, voffA);
            PG8_BAR; PG8_WAIT_L(0); PG8_MMA(1, 0, At, B0); PG8_BAR; PG8_SCHED;
            PG8_STAGE(PG8_SB(0, 1), b2 + hstep, voffB);
            PG8_WAIT_V(6); PG8_BAR; PG8_MMA(1, 1, At, B1); PG8_BAR;
            PG8_LDB(B0, 1, 0); PG8_SCHED; PG8_LDA(At, 1, 0); PG8_STAGE(PG8_SA(0, 1), a2 + hstep, voffA);
            PG8_WAIT_L(8); PG8_BAR; PG8_WAIT_L(0); PG8_MMA(0, 0, At, B0); PG8_BAR; PG8_SCHED;
            PG8_LDB(B1, 1, 1); PG8_STAGE(PG8_SB(1, 0), b3, voffB);
            PG8_BAR; PG8_WAIT_L(0); PG8_MMA(0, 1, At, B1); PG8_BAR;
            PG8_LDA(At, 1, 1); PG8_STAGE(PG8_SA(1, 0), a3, voffA);
            PG8_BAR; PG8_WAIT_L(0); PG8_MMA(1, 0, At, B0); PG8_BAR; PG8_SCHED;
            PG8_STAGE(PG8_SB(1, 1), b3 + hstep, voffB);
            PG8_WAIT_V(6); PG8_BAR; PG8_MMA(1, 1, At, B1); PG8_BAR;
        }
        if constexpr (!Epi::AFTER_DRAIN) { E(acc, cur, wr, wc, fr, fq); S.done(cur); }
        if (!has_next) break;
        if (!Epi::HOOKS)
#pragma unroll
        for (int a = 0; a < 2; ++a)
#pragma unroll
            for (int b = 0; b < 2; ++b)
#pragma unroll
                for (int m = 0; m < 4; ++m)
#pragma unroll
                    for (int n = 0; n < 2; ++n) acc[a][b][m][n] = (f32x4){0.f, 0.f, 0.f, 0.f};
        cur = nxt; cA = nA; cB = nB; ++ui;
    }
    PG8_WAIT_V(0);
    if (wr == 0) PG8_BAR;
    PG8_BAR;
    if constexpr (Epi::AFTER_DRAIN) { E.fused(acc, cur, wr, wc, fr, fq, lds, wid, lane); S.done(cur); }
#undef PG8_SA
#undef PG8_SB
#undef PG8_STAGE
#undef PG8_LDA
#undef PG8_LDB
#undef PG8_MMA
#undef PG8_WAIT_V
#undef PG8_WAIT_L
#undef PG8_BAR
#undef PG8_SCHED
}
}

__device__ __forceinline__ void tr_item(const float* __restrict__ W, int ldw, int k0, int c0, bf16_t* WT, int ldt, int d0, int kd0, const float* __restrict__ kscale, LAS float* scr, int lane) {
#pragma unroll 8
    for (int i = 0; i < 32; ++i) { const int kk = 2 * i + (lane >> 5); float v = W[(size_t)(k0 + kk) * ldw + c0 + (lane & 31)]; if (kscale) v *= kscale[k0 + kk]; scr[kk * 33 + (lane & 31)] = v; }
    LDS_WAIT();
    const int c = lane & 7;
#pragma unroll
    for (int j = 0; j < 4; ++j) { const int n = (lane >> 3) + 8 * j; const LAS float* s = scr + (8 * c) * 33 + n;
        u32x4 o; o.x = cvt_pk_bf16(s[0], s[33]); o.y = cvt_pk_bf16(s[66], s[99]); o.z = cvt_pk_bf16(s[132], s[165]); o.w = cvt_pk_bf16(s[198], s[231]);
        *(u32x4*)(WT + (size_t)(d0 + n) * ldt + kd0 + 8 * c) = o; }
    LDS_WAIT();
}

__device__ __forceinline__ void phase0(const Params& p, LAS unsigned char* lds) {
    const int tid = threadIdx.x, lane = tid & 63, wave = tid >> 6, G = gridDim.x;
    const int gw = blockIdx.x * 8 + wave, NGW = G * 8;
    unsigned char* ws = p.ws;
    bf16_t* WIN = (bf16_t*)(ws + WS_WIN); bf16_t* WCAT = (bf16_t*)(ws + WS_WCAT); bf16_t* WOUT = (bf16_t*)(ws + WS_WOUT); bf16_t* PMIX = (bf16_t*)(ws + WS_PMIX);
    bf16_t* HB = (bf16_t*)(p.out + O_YP); float* DT = (float*)(ws + WS_DT);
    { float* z = (float*)(ws + WS_SSQ); for (int i = blockIdx.x * 512 + tid; i < 3 * MTOK; i += G * 512) z[i] = 0.f;
      if (blockIdx.x == 0 && tid == 0) *(unsigned*)(ws + WS_CTL) = 0u; }
    LAS float* wdt = (LAS float*)lds;
    for (int e = tid; e < 4096; e += 512) { const int k = e >> 2, j4 = e & 3; const f32x4 v = *(const f32x4*)(p.w_in + (size_t)k * DIN + 2560 + 4 * j4);
        wdt[(4 * j4 + 0) * 1024 + k] = v.x; wdt[(4 * j4 + 1) * 1024 + k] = v.y; wdt[(4 * j4 + 2) * 1024 + k] = v.z; wdt[(4 * j4 + 3) * 1024 + k] = v.w; }
    LAS float* scr = (LAS float*)(lds + 65536 + wave * 8448);
    constexpr int I_IN = 16 * 176, I_A = 16 * 32, I_B = 8 * 32, I_O = 16 * 32, I_P = 4 * 8, NIT = I_IN + I_A + I_B + I_O + I_P;
    for (int it = gw; it < NIT; it += NGW) {
        int r = it;
        if (r < I_IN) { const int kb = r / 176, nb = r % 176, d0 = 32 * nb, c0 = d0 + (d0 >= 2560 ? 16 : 0); tr_item(p.w_in, DIN, 64 * kb, c0, WIN, 1024, d0, 64 * kb, nullptr, scr, lane); continue; } r -= I_IN;
        if (r < I_A) { const int kb = r >> 5, nb = r & 31; tr_item(p.w_a, 1024, 64 * kb, 32 * nb, WCAT, KCAT, 32 * nb, 64 * kb, p.ssm_norm, scr, lane); continue; } r -= I_A;
        if (r < I_B) { const int kb = r >> 5, nb = r & 31; tr_item(p.w_b, 1024, 64 * kb, 32 * nb, WCAT, KCAT, 32 * nb, 1024 + 64 * kb, nullptr, scr, lane); continue; } r -= I_B;
        if (r < I_O) { const int kb = r >> 5, nb = r & 31; tr_item(p.w_out, 1024, 64 * kb, 32 * nb, WOUT, 1024, 32 * nb, 64 * kb, nullptr, scr, lane); continue; } r -= I_O;
        { const int k = r >> 3, kb = (r >> 2) & 1, nb = r & 3; tr_item(p.pool_mix + (size_t)k * 16384, 128, 64 * kb, 32 * nb, PMIX + (size_t)k * 16384, 128, 32 * nb, 64 * kb, nullptr, scr, lane); }
    }
    __syncthreads();
    const float dtb = p.dt_bias[lane & 15];
    for (int m = gw; m < MTOK; m += NGW) {
        const float* xrow = m < NTOK_P ? p.x_p + (size_t)m * DM : p.x_s + (size_t)(m - NTOK_P) * DM;
        f32x4 v[4]; float ss = 0.f;
#pragma unroll
        for (int j = 0; j < 4; ++j) { v[j] = ((const f32x4*)xrow)[lane + 64 * j]; ss += (v[j].x * v[j].x + v[j].y * v[j].y) + (v[j].z * v[j].z + v[j].w * v[j].w); }
        const float rstd = rsqrtf(wave_sum(ss) * (1.f / DM) + EPS);
        unsigned long long* o8 = (unsigned long long*)(HB + (size_t)m * DM);
#pragma unroll
        for (int j = 0; j < 4; ++j) { const f32x4 g4 = ((const f32x4*)p.norm_pre)[lane + 64 * j]; v[j] = v[j] * rstd * g4;
            o8[lane + 64 * j] = (unsigned long long)cvt_pk_bf16(v[j].x, v[j].y) | ((unsigned long long)cvt_pk_bf16(v[j].z, v[j].w) << 32); }
        float mine = 0.f;
#pragma unroll
        for (int jj = 0; jj < 16; ++jj) { float s = 0.f;
#pragma unroll
            for (int j = 0; j < 4; ++j) { const f32x4 w4 = *(const LAS f32x4*)(wdt + jj * 1024 + 4 * lane + 256 * j); s += (v[j].x * w4.x + v[j].y * w4.y) + (v[j].z * w4.z + v[j].w * w4.w); }
            s = wave_sum(s); if (lane == jj) mine = s; }
        if (lane < 16) { const float a = mine + dtb; DT[(size_t)m * 16 + lane] = a > 20.f ? a : log1pf(__expf(a)); }
    }
}

constexpr int PIT = 272;
constexpr int OFF_C = 0, OFF_B = 34816, OFF_BT = 69632, OFF_XT = 104448, OFF_H = 121856, OFF_SM = 139264, OFF_MISC = OFF_SM + 2048;
static_assert(OFF_MISC + 64 <= LDS_BYTES, "lds");

template <int NT> __device__ __forceinline__ void conv_pair(const bf16_t* __restrict__ colp, int tb, const float (&w)[4][2], const float (&bias)[2], float (&out)[NT][2]) {
    unsigned raw[NT + 3];
#pragma unroll
    for (int i = 0; i < NT + 3; ++i) raw[i] = (tb - 3 + i) >= 0 ? *(const unsigned*)(colp + (ptrdiff_t)(i - 3) * NPROJ) : 0u;
#pragma unroll
    for (int i = 0; i < NT; ++i) {
        float v0 = bias[0], v1 = bias[1];
#pragma unroll
        for (int k = 0; k < 4; ++k) { v0 += w[k][0] * bf_lo(raw[i + k]); v1 += w[k][1] * bf_hi(raw[i + k]); }
        out[i][0] = silu_f(v0); out[i][1] = silu_f(v1);
    }
}

__device__ __forceinline__ void ssd_prompt_item(const Params& p, LAS unsigned char* lds, int item) {
    const int tid = threadIdx.x, wid = __builtin_amdgcn_readfirstlane(tid >> 6), lane = tid & 63, r = lane & 15, q = lane >> 4;
    const int b = item >> 4, head = item & 15, g = head >> 3;
    const bf16_t* PROJ = (const bf16_t*)(p.ws + WS_PROJ); const float* DT = (const float*)(p.ws + WS_DT); float* SSQ = (float*)(p.ws + WS_SSQ);
    bf16_t* YCAT = (bf16_t*)(p.out + O_YP);
    const float a_h = -__expf(p.a_log[head]), Dh = p.d_skip[head];
    LAS float* dts = (LAS float*)(lds + OFF_SM); LAS float* acs = dts + 128; LAS float* wsd = dts + 256; LAS float* misc = dts + 384;
    const int xp = tid & 31, xseg = tid >> 5, bp = tid & 63, bseg = tid >> 6;
    const int chx = head * 64 + 2 * xp, chb = 1024 + g * 128 + 2 * bp, chc = 1280 + g * 128 + 2 * bp;
    float wx[4][2], wb[4][2], wcc[4][2], bx[2], bb[2], bc[2];
#pragma unroll
    for (int k = 0; k < 4; ++k)
#pragma unroll
        for (int e = 0; e < 2; ++e) { wx[k][e] = p.conv_w[k * CONVD + chx + e]; wb[k][e] = p.conv_w[k * CONVD + chb + e]; wcc[k][e] = p.conv_w[k * CONVD + chc + e]; }
#pragma unroll
    for (int e = 0; e < 2; ++e) { bx[e] = p.conv_b[chx + e]; bb[e] = p.conv_b[chb + e]; bc[e] = p.conv_b[chc + e]; }
    f32x4 hacc[4];
#pragma unroll
    for (int i = 0; i < 4; ++i) hacc[i] = (f32x4){0.f, 0.f, 0.f, 0.f};
    for (int i = tid; i < 17408 / 4; i += 512) ((LAS unsigned*)(lds + OFF_H))[i] = 0u;
    const size_t row00 = (size_t)b * SEQ;
    float dtn0 = 0.f, dtn1 = 0.f;
    if (wid == 0) { dtn0 = DT[(row00 + 2 * lane) * 16 + head]; dtn1 = DT[(row00 + 2 * lane + 1) * 16 + head]; }
    const int lt = wid, l0 = 16 * wid;
    for (int c = 0; c < SEQ / 128; ++c) {
        const size_t rowb = row00 + (size_t)c * 128;
        if (wid == 0) {
            const float d0 = dtn0, d1 = dtn1, v0 = d0 * a_h, v1 = d1 * a_h;
            if (c + 1 < SEQ / 128) { dtn0 = DT[(rowb + 128 + 2 * lane) * 16 + head]; dtn1 = DT[(rowb + 128 + 2 * lane + 1) * 16 + head]; }
            float x = v0 + v1;
#pragma unroll
            for (int o = 1; o < 64; o <<= 1) { const float t = __shfl_up(x, o); if (lane >= o) x += t; }
            const float tot = __shfl(x, 63), a1 = x, a0 = x - v1;
            dts[2 * lane] = d0; dts[2 * lane + 1] = d1; acs[2 * lane] = a0; acs[2 * lane + 1] = a1;
            wsd[2 * lane] = d0 * __expf(tot - a0); wsd[2 * lane + 1] = d1 * __expf(tot - a1);
            if (lane == 0) misc[0] = __expf(tot);
        }
        __syncthreads();
        {   float o[8][2];
            conv_pair<8>(PROJ + (rowb + xseg * 8) * NPROJ + C_XBC + chx, c * 128 + xseg * 8, wx, bx, o);
#pragma unroll
            for (int e = 0; e < 2; ++e) { u32x4 w; w.x = cvt_pk_bf16(o[0][e], o[1][e]); w.y = cvt_pk_bf16(o[2][e], o[3][e]); w.z = cvt_pk_bf16(o[4][e], o[5][e]); w.w = cvt_pk_bf16(o[6][e], o[7][e]);
                *(LAS u32x4*)(lds + OFF_XT + (2 * xp + e) * PIT + xseg * 16) = w; }
        }
        {   float o[16][2];
            conv_pair<16>(PROJ + (rowb + bseg * 16) * NPROJ + C_XBC + chb, c * 128 + bseg * 16, wb, bb, o);
#pragma unroll
            for (int i = 0; i < 16; ++i) *(LAS unsigned*)(lds + OFF_B + (bseg * 16 + i) * PIT + bp * 4) = cvt_pk_bf16(o[i][0], o[i][1]);
            float wv[16];
#pragma unroll
            for (int i = 0; i < 4; ++i) { const f32x4 t = *(const LAS f32x4*)(wsd + bseg * 16 + 4 * i); wv[4 * i] = t.x; wv[4 * i + 1] = t.y; wv[4 * i + 2] = t.z; wv[4 * i + 3] = t.w; }
#pragma unroll
            for (int e = 0; e < 2; ++e)
#pragma unroll
                for (int hh = 0; hh < 2; ++hh) { u32x4 w;
                    w.x = cvt_pk_bf16(o[8 * hh + 0][e] * wv[8 * hh + 0], o[8 * hh + 1][e] * wv[8 * hh + 1]); w.y = cvt_pk_bf16(o[8 * hh + 2][e] * wv[8 * hh + 2], o[8 * hh + 3][e] * wv[8 * hh + 3]);
                    w.z = cvt_pk_bf16(o[8 * hh + 4][e] * wv[8 * hh + 4], o[8 * hh + 5][e] * wv[8 * hh + 5]); w.w = cvt_pk_bf16(o[8 * hh + 6][e] * wv[8 * hh + 6], o[8 * hh + 7][e] * wv[8 * hh + 7]);
                    *(LAS u32x4*)(lds + OFF_BT + (2 * bp + e) * PIT + bseg * 32 + hh * 16) = w; }
        }
        {   float o[16][2];
            conv_pair<16>(PROJ + (rowb + bseg * 16) * NPROJ + C_XBC + chc, c * 128 + bseg * 16, wcc, bc, o);
#pragma unroll
            for (int i = 0; i < 16; ++i) *(LAS unsigned*)(lds + OFF_C + (bseg * 16 + i) * PIT + bp * 4) = cvt_pk_bf16(o[i][0], o[i][1]);
        }
        __syncthreads();
        bf16x8 cf[4];
#pragma unroll
        for (int kk = 0; kk < 4; ++kk) cf[kk] = *(const LAS bf16x8*)(lds + OFF_C + (l0 + r) * PIT + kk * 64 + q * 16);
        f32x4 gacc[8];
#pragma unroll
        for (int st = 0; st < 8; ++st) { gacc[st] = (f32x4){0.f, 0.f, 0.f, 0.f};
            if (st <= lt) {
#pragma unroll
                for (int kk = 0; kk < 4; ++kk) { const bf16x8 bf = *(const LAS bf16x8*)(lds + OFF_B + (16 * st + r) * PIT + kk * 64 + q * 16); gacc[st] = MFMA16(bf, cf[kk], gacc[st]); } } }
        __syncthreads();
        const float acl = acs[l0 + r];
#pragma unroll
        for (int st = 0; st < 8; ++st) {
            if (st <= (lt | 1)) { const int s0 = 16 * st + 4 * q; const f32x4 as = *(const LAS f32x4*)(acs + s0), ds = *(const LAS f32x4*)(dts + s0); float mv[4];
#pragma unroll
                for (int j = 0; j < 4; ++j) { const bool ok = (st <= lt) && (l0 + r >= s0 + j); mv[j] = ok ? gacc[st][j] * __expf(acl - as[j]) * ds[j] : 0.f; }
                u32x2 w; w.x = cvt_pk_bf16(mv[0], mv[1]); w.y = cvt_pk_bf16(mv[2], mv[3]);
                *(LAS u32x2*)(lds + OFF_B + (l0 + r) * PIT + s0 * 2) = w; } }
        __syncthreads();
        f32x4 yd[4], yo[4];
#pragma unroll
        for (int i = 0; i < 4; ++i) { yd[i] = (f32x4){0.f, 0.f, 0.f, 0.f}; yo[i] = (f32x4){0.f, 0.f, 0.f, 0.f}; }
        const int kmax = lt >> 1;
#pragma unroll
        for (int kk = 0; kk < 4; ++kk) {
            if (kk <= kmax) { const bf16x8 mf = *(const LAS bf16x8*)(lds + OFF_B + (l0 + r) * PIT + kk * 64 + q * 16);
#pragma unroll
                for (int pt = 0; pt < 4; ++pt) { const bf16x8 xf = *(const LAS bf16x8*)(lds + OFF_XT + (16 * pt + r) * PIT + kk * 64 + q * 16); yd[pt] = MFMA16(xf, mf, yd[pt]); } }
#pragma unroll
            for (int pt = 0; pt < 4; ++pt) { const bf16x8 hf = *(const LAS bf16x8*)(lds + OFF_H + (16 * pt + r) * PIT + kk * 64 + q * 16); yo[pt] = MFMA16(hf, cf[kk], yo[pt]); }
        }
        { const float eend = misc[0];
#pragma unroll
          for (int pt = 0; pt < 4; ++pt) hacc[pt] *= eend;
#pragma unroll
          for (int kk = 0; kk < 4; ++kk) { const bf16x8 btf = *(const LAS bf16x8*)(lds + OFF_BT + (16 * wid + r) * PIT + kk * 64 + q * 16);
#pragma unroll
              for (int pt = 0; pt < 4; ++pt) { const bf16x8 xf = *(const LAS bf16x8*)(lds + OFF_XT + (16 * pt + r) * PIT + kk * 64 + q * 16); hacc[pt] = MFMA16(btf, xf, hacc[pt]); } } }
        { const float el = __expf(acl); const size_t row = rowb + l0 + r; float ss = 0.f;
#pragma unroll
          for (int pt = 0; pt < 4; ++pt) { const int p0 = 16 * pt + 4 * q; const u32x2 z2 = *(const u32x2*)(PROJ + row * NPROJ + C_Z + head * 64 + p0); float y[4];
#pragma unroll
              for (int j = 0; j < 4; ++j) { const float xv = bf2f(*(const LAS bf16_t*)(lds + OFF_XT + (p0 + j) * PIT + (l0 + r) * 2));
                  const unsigned zw = (j < 2) ? z2.x : z2.y; const float zv = (j & 1) ? bf_hi(zw) : bf_lo(zw);
                  y[j] = (yd[pt][j] + el * yo[pt][j] + Dh * xv) * silu_f(zv); ss += y[j] * y[j]; }
              u32x2 w; w.x = cvt_pk_bf16(y[0], y[1]); w.y = cvt_pk_bf16(y[2], y[3]);
              *(u32x2*)(YCAT + row * KCAT + head * 64 + p0) = w; }
          ss += __shfl_xor(ss, 16); ss += __shfl_xor(ss, 32);
          if (q == 0) atomicAdd(SSQ + row * 2 + g, ss); }
        __syncthreads();
#pragma unroll
        for (int pt = 0; pt < 4; ++pt) { u32x2 w; w.x = cvt_pk_bf16(hacc[pt][0], hacc[pt][1]); w.y = cvt_pk_bf16(hacc[pt][2], hacc[pt][3]);
            *(LAS u32x2*)(lds + OFF_H + (16 * pt + r) * PIT + (16 * wid + 4 * q) * 2) = w; }
    }
    float* so = p.out + O_SSMP + ((size_t)(b * NH + head) * HD) * DS;
#pragma unroll
    for (int pt = 0; pt < 4; ++pt) *(f32x4*)(so + (size_t)(16 * pt + r) * DS + 16 * wid + 4 * q) = hacc[pt];
}

__device__ __forceinline__ void pool_item(const Params& p, LAS unsigned char* lds, int j) {
    const int tid = threadIdx.x, wid = __builtin_amdgcn_readfirstlane(tid >> 6), lane = tid & 63, r = lane & 15, q = lane >> 4;
    const bf16_t* PROJ = (const bf16_t*)(p.ws + WS_PROJ); const bf16_t* PMIX = (const bf16_t*)(p.ws + WS_PMIX); bf16_t* YCAT = (bf16_t*)(p.out + O_YP);
    const int row0 = 128 * j; const bool prompt = row0 < NTOK_P;
    const int cp = tid & 63, ts0 = (tid >> 6) * 16;
    for (int k = 0; k < 4; ++k) {
        const int W = 2 << k; const float invW = 1.f / (float)W;
        const bf16_t* ucol = PROJ + C_U + k * 128 + 2 * cp;
        if (prompt) {
            const int tb = (row0 & (SEQ - 1)) + ts0; const size_t rw = (size_t)row0 + ts0;
            float r0 = 0.f, r1 = 0.f;
            for (int jb = 1; jb < W; ++jb) if (tb - jb >= 0) { const unsigned u = *(const unsigned*)(ucol + (rw - jb) * NPROJ); r0 += bf_lo(u); r1 += bf_hi(u); }
#pragma unroll 4
            for (int i = 0; i < 16; ++i) { const unsigned u = *(const unsigned*)(ucol + (rw + i) * NPROJ); const float c0 = bf_lo(u), c1 = bf_hi(u); r0 += c0; r1 += c1;
                const int cnt = min(tb + i + 1, W); const float ic = 1.f / (float)cnt;
                *(LAS unsigned*)(lds + (ts0 + i) * PIT + cp * 4) = cvt_pk_bf16(r0 * ic - c0, r1 * ic - c1);
                if (tb + i - W + 1 >= 0) { const unsigned uo = *(const unsigned*)(ucol + (rw + i - W + 1) * NPROJ); r0 -= bf_lo(uo); r1 -= bf_hi(uo); } }
        } else {
            for (int i = 0; i < 16; ++i) { const int row = row0 + ts0 + i, sidx = row - NTOK_P, bb = sidx >> 3, t = sidx & 7; float s0 = 0.f, s1 = 0.f, c0 = 0.f, c1 = 0.f;
                for (int jb = 0; jb < W; ++jb) { const int e = t - jb; float v0, v1;
                    if (e >= 0) { const unsigned u = *(const unsigned*)(ucol + (size_t)(row - jb) * NPROJ); v0 = bf_lo(u); v1 = bf_hi(u); }
                    else { const f32x2 sv = *(const f32x2*)(p.st_pool + ((size_t)bb * 15 + 15 + e) * DPOOL + k * 128 + 2 * cp); v0 = sv.x; v1 = sv.y; }
                    if (jb == 0) { c0 = v0; c1 = v1; } s0 += v0; s1 += v1; }
                *(LAS unsigned*)(lds + (ts0 + i) * PIT + cp * 4) = cvt_pk_bf16(s0 * invW - c0, s1 * invW - c1); }
        }
        __syncthreads();
        bf16x8 mf[4];
#pragma unroll
        for (int kk = 0; kk < 4; ++kk) mf[kk] = *(const bf16x8*)(PMIX + ((size_t)k * 128 + 16 * wid + r) * 128 + kk * 32 + q * 8);
        const int d0 = k * 128 + 16 * wid + 4 * q; const f32x4 sc = *(const f32x4*)(p.pool_scale + d0);
#pragma unroll 2
        for (int tt = 0; tt < 8; ++tt) { f32x4 acc = (f32x4){0.f, 0.f, 0.f, 0.f};
#pragma unroll
            for (int kk = 0; kk < 4; ++kk) { const bf16x8 af = *(const LAS bf16x8*)(lds + (16 * tt + r) * PIT + kk * 64 + q * 16); acc = MFMA16(mf[kk], af, acc); }
            const size_t row = (size_t)row0 + 16 * tt + r; const u32x2 g2 = *(const u32x2*)(PROJ + row * NPROJ + C_G + d0);
            const float y0 = acc[0] * sc.x * silu_f(bf_lo(g2.x)), y1 = acc[1] * sc.y * silu_f(bf_hi(g2.x)), y2 = acc[2] * sc.z * silu_f(bf_lo(g2.y)), y3 = acc[3] * sc.w * silu_f(bf_hi(g2.y));
            u32x2 w; w.x = cvt_pk_bf16(y0, y1); w.y = cvt_pk_bf16(y2, y3);
            *(u32x2*)(YCAT + row * KCAT + 1024 + d0) = w; }
        __syncthreads();
    }
}

__device__ __forceinline__ void ssd_sample_item(const Params& p, LAS unsigned char* lds, int it) {
    const int tid = threadIdx.x, lane = tid & 63;
    const int b = it >> 4, head = it & 15, g = head >> 3;
    const bf16_t* PROJ = (const bf16_t*)(p.ws + WS_PROJ); const float* DT = (const float*)(p.ws + WS_DT); float* SSQ = (float*)(p.ws + WS_SSQ); bf16_t* YCAT = (bf16_t*)(p.out + O_YP);
    LAS float* xs = (LAS float*)lds; LAS float* Bs = xs + 512; LAS float* Cs = Bs + 1024; LAS float* Gs = Cs + 1024; LAS float* yo = Gs + 64; LAS float* sdt = yo + 512; LAS float* sac = sdt + 8;
    const size_t row0 = (size_t)NTOK_P + (size_t)b * LS;
    for (int e = tid; e < 2560; e += 512) { const int t = e / 320, c = e % 320;
        const int ch = c < 64 ? head * 64 + c : (c < 192 ? 1024 + g * 128 + (c - 64) : 1280 + g * 128 + (c - 192));
        float v = p.conv_b[ch];
#pragma unroll
        for (int k = 0; k < 4; ++k) { const int ei = t + k;
            const float val = ei < 3 ? p.st_conv[((size_t)b * 3 + ei) * CONVD + ch] : bf2f(PROJ[(row0 + ei - 3) * NPROJ + C_XBC + ch]);
            v += val * p.conv_w[k * CONVD + ch]; }
        v = silu_f(v);
        if (c < 64) xs[t * 64 + c] = v; else if (c < 192) Bs[t * 128 + c - 64] = v; else Cs[t * 128 + c - 192] = v; }
    const float a_h = -__expf(p.a_log[head]), Dh = p.d_skip[head];
    float dt[8], ac[8]; { float run = 0.f;
#pragma unroll
        for (int t = 0; t < 8; ++t) { dt[t] = DT[(row0 + t) * 16 + head]; run += dt[t] * a_h; ac[t] = run; } }
    if (tid < 8) { float dsel = 0.f, asel = 0.f;
#pragma unroll
        for (int t = 0; t < 8; ++t) if (tid == t) { dsel = dt[t]; asel = ac[t]; }
        sdt[tid] = dsel; sac[tid] = asel; }
    const int n4 = tid & 31, prow = tid >> 5;
    const float* hin = p.st_ssm + ((size_t)(b * NH + head) * HD) * DS; float* hout = p.out + O_SSMS + ((size_t)(b * NH + head) * HD) * DS;
    f32x4 h[4];
#pragma unroll
    for (int i = 0; i < 4; ++i) h[i] = *(const f32x4*)(hin + (size_t)(prow + 16 * i) * DS + 4 * n4);
    __syncthreads();
    if (tid < 64) { const int l = tid >> 3, s = tid & 7; float acc = 0.f;
        for (int n = 0; n < 128; n += 4) { const f32x4 cv = *(const LAS f32x4*)(Cs + l * 128 + n), bv = *(const LAS f32x4*)(Bs + s * 128 + n); acc += (cv.x * bv.x + cv.y * bv.y) + (cv.z * bv.z + cv.w * bv.w); }
        Gs[tid] = acc; }
    {   float part[8][4];
#pragma unroll
        for (int l = 0; l < 8; ++l) { const f32x4 cv = *(const LAS f32x4*)(Cs + l * 128 + 4 * n4);
#pragma unroll
            for (int i = 0; i < 4; ++i) part[l][i] = (cv.x * h[i].x + cv.y * h[i].y) + (cv.z * h[i].z + cv.w * h[i].w); }
#pragma unroll
        for (int o = 1; o < 32; o <<= 1)
#pragma unroll
            for (int l = 0; l < 8; ++l)
#pragma unroll
                for (int i = 0; i < 4; ++i) part[l][i] += __shfl_xor(part[l][i], o);
        if (n4 == 0) {
#pragma unroll
            for (int l = 0; l < 8; ++l)
#pragma unroll
                for (int i = 0; i < 4; ++i) yo[l * 64 + prow + 16 * i] = part[l][i]; }
    }
    {   const float eend = __expf(ac[7]); f32x4 hn[4];
#pragma unroll
        for (int i = 0; i < 4; ++i) hn[i] = h[i] * eend;
#pragma unroll
        for (int s = 0; s < 8; ++s) { const float w = dt[s] * __expf(ac[7] - ac[s]); const f32x4 bv = *(const LAS f32x4*)(Bs + s * 128 + 4 * n4);
#pragma unroll
            for (int i = 0; i < 4; ++i) { const float xv = xs[s * 64 + prow + 16 * i] * w; hn[i] += bv * xv; } }
#pragma unroll
        for (int i = 0; i < 4; ++i) *(f32x4*)(hout + (size_t)(prow + 16 * i) * DS + 4 * n4) = hn[i];
    }
    __syncthreads();
    {   const int l = tid >> 6, pp = lane; const float al = sac[l];
        float y = __expf(al) * yo[l * 64 + pp];
        for (int s = 0; s <= l; ++s) y += Gs[l * 8 + s] * __expf(al - sac[s]) * sdt[s] * xs[s * 64 + pp];
        y += Dh * xs[l * 64 + pp];
        const float zv = bf2f(PROJ[(row0 + l) * NPROJ + C_Z + head * 64 + pp]);
        y *= silu_f(zv);
        const float ss = wave_sum(y * y);
        if (lane == 0) atomicAdd(SSQ + (row0 + l) * 2 + g, ss);
        YCAT[(row0 + l) * KCAT + head * 64 + pp] = (bf16_t)(cvt_pk_bf16(y, 0.f) & 0xffffu);
    }
    __syncthreads();
}

constexpr int E_CP = NB_P * 3 * CONVD, E_PP = NB_P * 15 * DPOOL, E_CS = NB_S * 3 * CONVD, E_PS = NB_S * 15 * DPOOL, E_ALL = E_CP + E_PP + E_CS + E_PS, N_COPY = 64;
__device__ __forceinline__ void copy_item(const Params& p, int it) {
    const bf16_t* PROJ = (const bf16_t*)(p.ws + WS_PROJ);
    constexpr int PER = E_ALL / N_COPY; static_assert(E_ALL % N_COPY == 0, "copy split");
    for (int e = it * PER + threadIdx.x; e < (it + 1) * PER; e += 512) {
        int r = e;
        if (r < E_CP) { const int b = r / (3 * CONVD), rem = r % (3 * CONVD), j = rem / CONVD, ch = rem % CONVD; p.out[O_CONVP + r] = bf2f(PROJ[((size_t)b * SEQ + SEQ - 3 + j) * NPROJ + C_XBC + ch]); continue; } r -= E_CP;
        if (r < E_PP) { const int b = r / (15 * DPOOL), rem = r % (15 * DPOOL), j = rem / DPOOL, ch = rem % DPOOL; p.out[O_POOLP + r] = bf2f(PROJ[((size_t)b * SEQ + SEQ - 15 + j) * NPROJ + C_U + ch]); continue; } r -= E_PP;
        if (r < E_CS) { const int b = r / (3 * CONVD), rem = r % (3 * CONVD), j = rem / CONVD, ch = rem % CONVD; p.out[O_CONVS + r] = bf2f(PROJ[((size_t)NTOK_P + b * LS + LS - 3 + j) * NPROJ + C_XBC + ch]); continue; } r -= E_CS;
        { const int b = r / (15 * DPOOL), rem = r % (15 * DPOOL), j = rem / DPOOL, ch = rem % DPOOL;
          p.out[O_POOLS + r] = j < 7 ? p.st_pool[((size_t)b * 15 + 8 + j) * DPOOL + ch] : bf2f(PROJ[((size_t)NTOK_P + b * LS + (j - 7)) * NPROJ + C_U + ch]); }
    }
}

constexpr int IT_SSD = NB_P * NH, IT_POOL = MTOK / 128, IT_SMP = NB_S * NH, IT_ALL = IT_SSD + IT_POOL + IT_SMP + N_COPY;
__device__ __forceinline__ void phase2(const Params& p, LAS unsigned char* lds) {
    unsigned* ctr = (unsigned*)(p.ws + WS_CTL);
    volatile LAS int* slot = (volatile LAS int*)(lds + OFF_MISC);
    for (;;) {
        __syncthreads();
        if (threadIdx.x == 0) slot[0] = (int)atomicAdd(ctr, 1u);
        __syncthreads();
        const int it = slot[0];
        if (it >= IT_ALL) break;
        if (it < IT_SSD) ssd_prompt_item(p, lds, it);
        else if (it < IT_SSD + IT_POOL) pool_item(p, lds, it - IT_SSD);
        else if (it < IT_SSD + IT_POOL + IT_SMP) ssd_sample_item(p, lds, it - IT_SSD - IT_POOL);
        else copy_item(p, it - IT_SSD - IT_POOL - IT_SMP);
    }
}

__device__ __forceinline__ void phase5(const Params& p) {
    const int tid = threadIdx.x, lane = tid & 63, wave = tid >> 6; const int gw = blockIdx.x * 8 + wave, NGW = gridDim.x * 8;
    const bf16_t* OUTB = (const bf16_t*)(p.ws + WS_PROJ); const float* SSQ2 = (const float*)(p.ws + WS_SSQ2);
    for (int m = gw; m < MTOK; m += NGW) {
        const float* xrow = m < NTOK_P ? p.x_p + (size_t)m * DM : p.x_s + (size_t)(m - NTOK_P) * DM;
        float* yrow = m < NTOK_P ? p.out + O_YP + (size_t)m * DM : p.out + O_YS + (size_t)(m - NTOK_P) * DM;
        const float rstd = rsqrtf(SSQ2[m] * (1.f / DM) + EPS);
#pragma unroll
        for (int j = 0; j < 4; ++j) { const f32x4 x4 = ((const f32x4*)xrow)[lane + 64 * j], g4 = ((const f32x4*)p.norm_post)[lane + 64 * j]; const u32x2 o2 = ((const u32x2*)(OUTB + (size_t)m * DM))[lane + 64 * j];
            f32x4 y; y.x = x4.x + bf_lo(o2.x) * rstd * g4.x; y.y = x4.y + bf_hi(o2.x) * rstd * g4.y; y.z = x4.z + bf_lo(o2.y) * rstd * g4.z; y.w = x4.w + bf_hi(o2.y) * rstd * g4.w;
            ((f32x4*)yrow)[lane + 64 * j] = y; }
    }
}

__global__ void __launch_bounds__(512, 2) fwd_kernel(Params p) {
    extern __shared__ __attribute__((aligned(16))) unsigned char smem[];
    LAS unsigned char* lds = (LAS unsigned char*)smem;
    cg::grid_group grid = cg::this_grid();
    unsigned char* ws = p.ws;
    const int lo = p.ph_lo, hi = p.ph_hi;
#define IN(k) (lo <= (k) && (k) < hi)
#define SEAM(k) do { if (IN(k) && IN((k) + 1)) grid.sync(); } while (0)
    if (IN(0)) phase0(p, lds);
    SEAM(0);
    if (IN(1)) { pg8::Gemm g{(const bf16_t*)(p.out + O_YP), (const bf16_t*)(ws + WS_WIN), MTOK, NPROJ, DM}; pg8::StaticOrder S; S.init(MTOK, NPROJ, (int)gridDim.x, (int)blockIdx.x);
        pg8::EpiStore E{(bf16_t*)(ws + WS_PROJ), NPROJ}; pg8::gemm_phase<pg8::EpiStore, pg8::StaticOrder>(lds, g, S, E); }
    SEAM(1);
    if (IN(2)) phase2(p, lds);
    SEAM(2);
    if (IN(3)) { pg8::Gemm g{(const bf16_t*)(p.out + O_YP), (const bf16_t*)(ws + WS_WCAT), MTOK, DM, KCAT}; pg8::SegOrder S; S.init(MTOK, DM, (int)gridDim.x, (int)blockIdx.x);
        pg8::EpiMerge E{(const bf16_t*)(ws + WS_PROJ), (const float*)(ws + WS_SSQ), (bf16_t*)(ws + WS_MERGED)}; pg8::gemm_phase<pg8::EpiMerge, pg8::SegOrder>(lds, g, S, E); }
    SEAM(3);
    if (IN(4)) { pg8::Gemm g{(const bf16_t*)(ws + WS_MERGED), (const bf16_t*)(ws + WS_WOUT), MTOK, DM, DM}; pg8::StaticOrder S; S.init(MTOK, DM, (int)gridDim.x, (int)blockIdx.x);
        pg8::EpiOut E{(bf16_t*)(ws + WS_PROJ), (float*)(ws + WS_SSQ2)}; pg8::gemm_phase<pg8::EpiOut, pg8::StaticOrder>(lds, g, S, E); }
    SEAM(4);
    if (IN(5)) phase5(p);
}

#ifndef N_LAUNCH_MODE
#define N_LAUNCH_MODE 6
#endif
extern "C" void kernel_launch(void* const* d_in, const int* in_sizes, int n_in, void* d_out, int out_size, void* d_ws, size_t ws_size, hipStream_t stream) {
    static int grid = 0;
    if (grid == 0) {
        if (n_in != 19 || (size_t)out_size != O_END || ws_size < WS_END) { fprintf(stderr, "kernel_launch: unexpected sizes n_in %d out %d ws %zu (need %zu)\n", n_in, out_size, ws_size, (size_t)WS_END); grid = -1; return; }
        int dev = 0, cus = 0, per_cu = 0;
        hipGetDevice(&dev); hipDeviceGetAttribute(&cus, hipDeviceAttributeMultiprocessorCount, dev);
        if (hipFuncSetAttribute((const void*)fwd_kernel, hipFuncAttributeMaxDynamicSharedMemorySize, LDS_BYTES) != hipSuccess) { fprintf(stderr, "kernel_launch: hipFuncSetAttribute failed\n"); grid = -1; return; }
        if (hipOccupancyMaxActiveBlocksPerMultiprocessor(&per_cu, (const void*)fwd_kernel, 512, LDS_BYTES) != hipSuccess || per_cu < 1) { fprintf(stderr, "kernel_launch: occupancy query failed (%d)\n", per_cu); grid = -1; return; }
        grid = cus;
    }
    if (grid <= 0) return;
    Params p{};
    const float** f = (const float**)&p;
    for (int i = 0; i < 19; ++i) f[i] = (const float*)d_in[i];
    p.out = (float*)d_out; p.ws = (unsigned char*)d_ws;
    if (N_LAUNCH_MODE == 1) {
        p.ph_lo = 0; p.ph_hi = 6; void* args[] = {&p};
        hipError_t e = hipLaunchCooperativeKernel((const void*)fwd_kernel, dim3(grid), dim3(512), args, LDS_BYTES, stream);
        if (e != hipSuccess) fprintf(stderr, "cooperative launch failed: %s (grid %d)\n", hipGetErrorString(e), grid);
    } else {
        for (int ph = 0; ph < 6; ++ph) { p.ph_lo = ph; p.ph_hi = ph + 1; hipLaunchKernelGGL(fwd_kernel, dim3(grid), dim3(512), LDS_BYTES, stream, p); }
    }
}
```

```cpp
#include <hip/hip_runtime.h>
#include <hip/hip_cooperative_groups.h>
#include <cstdio>
#include <cstdint>
namespace cg = cooperative_groups;

#define LAS __attribute__((address_space(3)))
typedef unsigned short bf16_t;
typedef short bf16x8 __attribute__((ext_vector_type(8)));
typedef float f32x4 __attribute__((ext_vector_type(4)));
typedef float f32x2 __attribute__((ext_vector_type(2)));
typedef unsigned u32x4 __attribute__((ext_vector_type(4)));
typedef unsigned u32x2 __attribute__((ext_vector_type(2)));

constexpr int DM = 1024, SEQ = 2048, NB_P = 8, NB_S = 128, LS = 8;
constexpr int NTOK_P = NB_P * SEQ, NTOK_S = NB_S * LS, MTOK = NTOK_P + NTOK_S;
constexpr int NPROJ = 5632;
constexpr int C_Z = 0, C_XBC = 1024, C_U = 2560, C_G = 3072, C_GATE = 3584;
constexpr int DIN = 5648, CONVD = 1536, NH = 16, HD = 64, DS = 128, DPOOL = 512, KCAT = 1536;
constexpr float EPS = 1e-6f;

constexpr size_t WS_CTL = 0;
constexpr size_t WS_SSQ = 4096;
constexpr size_t WS_SSQ2 = WS_SSQ + (size_t)MTOK * 2 * 4;
constexpr size_t WS_DT = WS_SSQ2 + (size_t)MTOK * 4;
constexpr size_t WS_WIN = (WS_DT + (size_t)MTOK * 16 * 4 + 255) / 256 * 256;
constexpr size_t WS_WCAT = WS_WIN + (size_t)NPROJ * DM * 2;
constexpr size_t WS_WOUT = WS_WCAT + (size_t)DM * KCAT * 2;
constexpr size_t WS_PMIX = WS_WOUT + (size_t)DM * DM * 2;
constexpr size_t WS_MERGED = WS_PMIX + (size_t)4 * 128 * 128 * 2;
constexpr size_t WS_PROJ = WS_MERGED + (size_t)MTOK * DM * 2;
constexpr size_t WS_END = WS_PROJ + (size_t)MTOK * NPROJ * 2;

constexpr size_t O_YP = 0, O_YS = O_YP + (size_t)NTOK_P * DM, O_CONVP = O_YS + (size_t)NTOK_S * DM, O_SSMP = O_CONVP + (size_t)NB_P * 3 * CONVD,
                 O_POOLP = O_SSMP + (size_t)NB_P * NH * HD * DS, O_CONVS = O_POOLP + (size_t)NB_P * 15 * DPOOL, O_SSMS = O_CONVS + (size_t)NB_S * 3 * CONVD,
                 O_POOLS = O_SSMS + (size_t)NB_S * NH * HD * DS, O_END = O_POOLS + (size_t)NB_S * 15 * DPOOL;

constexpr int LDS_BYTES = 147456;

struct Params {
    const float *x_p, *x_s, *st_conv, *st_ssm, *st_pool, *norm_pre, *w_in, *conv_w, *conv_b, *dt_bias, *a_log, *d_skip, *ssm_norm, *w_a, *pool_mix, *pool_scale, *w_b, *w_out, *norm_post;
    float* out; unsigned char* ws; int ph_lo, ph_hi;
};

__device__ __forceinline__ unsigned cvt_pk_bf16(float lo, float hi) { unsigned r; asm("v_cvt_pk_bf16_f32 %0, %1, %2" : "=v"(r) : "v"(lo), "v"(hi)); return r; }
__device__ __forceinline__ float bf_lo(unsigned u) { return __uint_as_float(u << 16); }
__device__ __forceinline__ float bf_hi(unsigned u) { return __uint_as_float(u & 0xffff0000u); }
__device__ __forceinline__ float bf2f(bf16_t v) { return __uint_as_float((unsigned)v << 16); }
__device__ __forceinline__ float silu_f(float v) { return v / (1.f + __expf(-v)); }
__device__ __forceinline__ float wave_sum(float v) {
#pragma unroll
    for (int o = 1; o < 64; o <<= 1) v += __shfl_xor(v, o);
    return v;
}
#define LDS_WAIT() asm volatile("s_waitcnt lgkmcnt(0)" ::: "memory")
#define MFMA16(a, b, c) __builtin_amdgcn_mfma_f32_16x16x32_bf16((a), (b), (c), 0, 0, 0)

namespace pg8 {
#define PG8_LAS __attribute__((address_space(3)))
typedef unsigned short bf16_t;
typedef short bf16x8 __attribute__((ext_vector_type(8)));
typedef float f32x4 __attribute__((ext_vector_type(4)));
typedef unsigned u32x4 __attribute__((ext_vector_type(4)));
constexpr int BM = 256, BK = 64, HALF = 128, HTB = HALF * BK * 2  , STAGE_BYTES = 8 * HTB, NXCD = 8, WGM = 8;

__host__ __device__ __forceinline__ int lds_byte(int r, int c) { const int st = (r >> 4) * 2 + (c >> 5), rr = r & 15, cc = c & 31, ob = rr * 64 + cc * 2; return st * 1024 + (ob ^ (((ob >> 9) & 1) << 5)); }
__host__ __device__ __forceinline__ void stage_rc(int b, int& R, int& C) { const int st = b / 1024, sb = b % 1024, swz = sb ^ (((sb >> 9) & 1) << 5); R = (st >> 1) * 16 + swz / 64; C = (st & 1) * 32 + (swz % 64) / 2; }
__host__ __device__ __forceinline__ int perm32(int rho) { const int n = rho >> 4, i = rho & 15; return 8 * (i >> 2) + 4 * n + (i & 3); }

struct Unit { int pm, pn, seg; };
struct Gemm { const bf16_t* A; const bf16_t* Bt; int M, N, K; };

struct StaticOrder {
    int nM, nN, nwg, G, c;
    __host__ __device__ void init(int M, int N, int G_, int c_) { nM = M / BM; nN = N / BM; nwg = nM * nN; G = G_; c = c_; }
    __host__ __device__ bool next(int i, Unit& u) const {
        const long L = (long)i * G + c; if (L >= nwg) return false;
        int wgid = (int)L; { const int q = nwg / NXCD, r = nwg % NXCD, xcd = wgid % NXCD, off = wgid / NXCD; wgid = (xcd < r ? xcd * (q + 1) : r * (q + 1) + (xcd - r) * q) + off; }
        const int nig = WGM * nN, gid = wgid / nig, fm = gid * WGM, gsz = (nM - fm) < WGM ? (nM - fm) : WGM;
        u.pm = fm + ((wgid % nig) % gsz); u.pn = (wgid % nig) / gsz; u.seg = 0; return true;
    }
    __device__ __forceinline__ void a_ready(const Unit&) const {}
    __device__ __forceinline__ void done(const Unit&) const {}
};

struct SegOrder : StaticOrder {
    __host__ __device__ bool next(int i, Unit& u) const { const bool ok = StaticOrder::next(i / 3, u); u.seg = i % 3; return ok; }
};

struct EpiStore {
    static constexpr bool PERM = true, AFTER_DRAIN = false, HOOKS = false;
    bf16_t* O; int ldc;
    __device__ __forceinline__ void operator()(const f32x4 (&acc)[2][2][4][2], const Unit& u, int wr, int wc, int fr, int fq) const {
        const int row0 = u.pm * BM + wr * 64 + fr, col0 = u.pn * BM + wc * 32 + 8 * fq;
#pragma unroll
        for (int ai = 0; ai < 2; ++ai)
#pragma unroll
            for (int m = 0; m < 4; ++m) { bf16_t* rowp = O + (size_t)(row0 + ai * HALF + m * 16) * ldc + col0;
#pragma unroll
                for (int bj = 0; bj < 2; ++bj) { const f32x4 v0 = acc[ai][bj][m][0], v1 = acc[ai][bj][m][1];
                    u32x4 w; w.x = ::cvt_pk_bf16(v0[0], v0[1]); w.y = ::cvt_pk_bf16(v0[2], v0[3]); w.z = ::cvt_pk_bf16(v1[0], v1[1]); w.w = ::cvt_pk_bf16(v1[2], v1[3]);
                    *(u32x4*)(rowp + bj * HALF) = w; } }
    }
};
struct EpiMerge {
    static constexpr bool PERM = true, AFTER_DRAIN = false, HOOKS = true;
    const bf16_t* proj; const float* ssq; bf16_t* O;
    __device__ __forceinline__ void operator()(f32x4 (&acc)[2][2][4][2], const Unit& u, int wr, int wc, int fr, int fq) const {
        int row0 = u.pm * BM + wr * 64 + fr, col0 = u.pn * BM + wc * 32 + 8 * fq;
        asm volatile("" : "+v"(row0), "+v"(col0));
        const char* pb = (const char*)proj; const int seg = u.seg;
#pragma unroll
        for (int ai = 0; ai < 2; ++ai)
#pragma unroll
            for (int m = 0; m < 4; ++m) { const int row = row0 + ai * HALF + m * 16; const ::f32x2 s = *(const ::f32x2*)((const char*)ssq + (unsigned)row * 8u);
                const float q1 = s.y * (1.f / 512.f) + ::EPS, r1 = rsqrtf(q1), rr = rsqrtf(s.x * (1.f / 512.f) + ::EPS) * __builtin_amdgcn_sqrtf(q1);
                const unsigned goff = ((unsigned)row * (unsigned)::NPROJ + (unsigned)(::C_GATE + col0)) * 2u, ooff = ((unsigned)row * (unsigned)::DM + (unsigned)col0) * 2u;
#pragma unroll
                for (int bj = 0; bj < 2; ++bj) { const u32x4 ga = *(const u32x4*)(pb + goff + bj * 256), gb = *(const u32x4*)(pb + goff + 2048 + bj * 256); float v[8];
#pragma unroll
                    for (int idx = 0; idx < 8; ++idx) { const unsigned wa = ga[idx >> 1], wb = gb[idx >> 1];
                        const float va = (idx & 1) ? ::bf_hi(wa) : ::bf_lo(wa), vb = (idx & 1) ? ::bf_hi(wb) : ::bf_lo(wb);
                        const float ea = 1.f + __expf(-va), eb = 1.f + __expf(-vb);
                        const float f = seg == 0 ? rr : (seg == 1 ? r1 * eb * __builtin_amdgcn_rcpf(ea) : __builtin_amdgcn_rcpf(eb));
                        v[idx] = acc[ai][bj][m][idx >> 2][idx & 3] * f; }
                    if (seg == 2) { u32x4 w; w.x = ::cvt_pk_bf16(v[0], v[1]); w.y = ::cvt_pk_bf16(v[2], v[3]); w.z = ::cvt_pk_bf16(v[4], v[5]); w.w = ::cvt_pk_bf16(v[6], v[7]);
                        *(u32x4*)((char*)O + ooff + bj * 256) = w; }
                    const float keep = seg == 2 ? 0.f : 1.f;
                    acc[ai][bj][m][0] = (f32x4){v[0], v[1], v[2], v[3]} * keep; acc[ai][bj][m][1] = (f32x4){v[4], v[5], v[6], v[7]} * keep;
                    asm volatile("" : "+v"(acc[ai][bj][m][0]), "+v"(acc[ai][bj][m][1]) :: "memory"); } }
    }
};
struct EpiOut {
    static constexpr bool PERM = true, AFTER_DRAIN = false, HOOKS = false;
    bf16_t* O; float* ssq2;
    __device__ __forceinline__ void operator()(const f32x4 (&acc)[2][2][4][2], const Unit& u, int wr, int wc, int fr, int fq) const {
        const int row0 = u.pm * BM + wr * 64 + fr, col0 = u.pn * BM + wc * 32 + 8 * fq;
#pragma unroll
        for (int ai = 0; ai < 2; ++ai)
#pragma unroll
            for (int m = 0; m < 4; ++m) { const int row = row0 + ai * HALF + m * 16; float ss = 0.f;
#pragma unroll
                for (int bj = 0; bj < 2; ++bj) { const f32x4 v0 = acc[ai][bj][m][0], v1 = acc[ai][bj][m][1];
                    ss += (v0[0] * v0[0] + v0[1] * v0[1]) + (v0[2] * v0[2] + v0[3] * v0[3]) + (v1[0] * v1[0] + v1[1] * v1[1]) + (v1[2] * v1[2] + v1[3] * v1[3]);
                    u32x4 w; w.x = ::cvt_pk_bf16(v0[0], v0[1]); w.y = ::cvt_pk_bf16(v0[2], v0[3]); w.z = ::cvt_pk_bf16(v1[0], v1[1]); w.w = ::cvt_pk_bf16(v1[2], v1[3]);
                    *(u32x4*)(O + (size_t)row * ::DM + col0 + bj * HALF) = w; }
                ss += __shfl_xor(ss, 16); ss += __shfl_xor(ss, 32);
                if (fq == 0) atomicAdd(ssq2 + row, ss); }
    }
};

template <class Epi, class Sched>
__device__ __forceinline__ void gemm_phase(PG8_LAS unsigned char* lds, const Gemm g, const Sched& S, const Epi& E) {
    const int tid = threadIdx.x, wid = __builtin_amdgcn_readfirstlane(tid >> 6), lane = tid & 63, wr = wid >> 2, wc = wid & 3, fr = lane & 15, fq = lane >> 4;
    const int K = g.K, nt = Epi::HOOKS ? 8 : K / BK;
    unsigned voffA[2], voffB[2];
#pragma unroll
    for (int i = 0; i < 2; ++i) { int R, C; stage_rc(tid * 16 + i * 8192, R, C); const int Rb = Epi::PERM ? ((R & ~31) + perm32(R & 31)) : R;
        voffA[i] = (unsigned)(R * K + C) * 2u; voffB[i] = (unsigned)(Rb * K + C) * 2u; }
    const size_t kstep = (size_t)(BK * 2);
    const size_t hstep = (size_t)HALF * K * 2;
    const size_t tstep = 2 * hstep;
    const unsigned ldsw = (unsigned)wid * 1024u;
    const int aoff = lds_byte(wr * 64 + fr, fq * 8), boff = lds_byte(wc * 32 + fr, fq * 8);
#define PG8_SA(b, h) (((b) * 2 + (h)) * HTB)
#define PG8_SB(b, h) ((4 + (b) * 2 + (h)) * HTB)
#define PG8_STAGE(bufoff, gbase, voff) do { _Pragma("unroll") for (int _i = 0; _i < 2; ++_i) \
        __builtin_amdgcn_global_load_lds((const unsigned*)((const char*)(gbase) + (voff)[_i]), (PG8_LAS unsigned*)(lds + (bufoff) + ldsw + _i * 8192), 16, 0, 0); } while (0)
#define PG8_LDA(dst, b, h) do { _Pragma("unroll") for (int m = 0; m < 4; ++m) _Pragma("unroll") for (int k = 0; k < 2; ++k) dst[m][k] = *(const PG8_LAS bf16x8*)(lds + PG8_SA(b, h) + aoff + m * 2048 + k * 1024); } while (0)
#define PG8_LDB(dst, b, h) do { _Pragma("unroll") for (int n = 0; n < 2; ++n) _Pragma("unroll") for (int k = 0; k < 2; ++k) dst[n][k] = *(const PG8_LAS bf16x8*)(lds + PG8_SB(b, h) + boff + n * 2048 + k * 1024); } while (0)
#define PG8_MMA(ai, bj, At, Bt) do { __builtin_amdgcn_s_setprio(1); _Pragma("unroll") for (int m = 0; m < 4; ++m) _Pragma("unroll") for (int n = 0; n < 2; ++n) _Pragma("unroll") for (int k = 0; k < 2; ++k) \
        acc[ai][bj][m][n] = __builtin_amdgcn_mfma_f32_16x16x32_bf16(Bt[n][k], At[m][k], acc[ai][bj][m][n], 0, 0, 0); __builtin_amdgcn_s_setprio(0); } while (0)
#define PG8_WAIT_V(n) asm volatile("s_waitcnt vmcnt(" #n ")" ::: "memory")
#define PG8_WAIT_L(n) asm volatile("s_waitcnt lgkmcnt(" #n ")" ::: "memory")
#define PG8_BAR __builtin_amdgcn_s_barrier()
#define PG8_SCHED __builtin_amdgcn_sched_barrier(0)
    Unit cur, nxt; int ui = 0;
    if (!S.next(0, cur)) return;
    f32x4 acc[2][2][4][2];
#pragma unroll
    for (int a = 0; a < 2; ++a)
#pragma unroll
        for (int b = 0; b < 2; ++b)
#pragma unroll
            for (int m = 0; m < 4; ++m)
#pragma unroll
                for (int n = 0; n < 2; ++n) acc[a][b][m][n] = (f32x4){0.f, 0.f, 0.f, 0.f};
    bf16x8 At[4][2], B0[2][2], B1[2][2];
    const char* cA = (const char*)g.A + (size_t)cur.pm * tstep + (Epi::HOOKS ? cur.seg * 1024 : 0); const char* cB = (const char*)g.Bt + (size_t)cur.pn * tstep + (Epi::HOOKS ? cur.seg * 1024 : 0);
    S.a_ready(cur);
    PG8_STAGE(PG8_SB(0, 0), cB, voffB); PG8_STAGE(PG8_SA(0, 0), cA, voffA); PG8_STAGE(PG8_SB(0, 1), cB + hstep, voffB); PG8_STAGE(PG8_SA(0, 1), cA + hstep, voffA);
    if (wr == 1) PG8_BAR;
    PG8_WAIT_V(4); PG8_BAR;
    PG8_STAGE(PG8_SB(1, 0), cB + kstep, voffB); PG8_STAGE(PG8_SA(1, 0), cA + kstep, voffA); PG8_STAGE(PG8_SB(1, 1), cB + hstep + kstep, voffB);
    PG8_WAIT_V(6); PG8_BAR;
    for (;;) {
        const bool has_next = S.next(ui + 1, nxt);
        const char* nA = has_next ? (const char*)g.A + (size_t)nxt.pm * tstep + (Epi::HOOKS ? nxt.seg * 1024 : 0) : cA; const char* nB = has_next ? (const char*)g.Bt + (size_t)nxt.pn * tstep + (Epi::HOOKS ? nxt.seg * 1024 : 0) : cB;
        for (int t = 0; t < nt; t += 2) {
            const bool last = (t == nt - 2);
            const char* a1 = cA + (size_t)(t + 1) * kstep;
            const char* a2 = last ? nA : cA + (size_t)(t + 2) * kstep; const char* b2 = last ? nB : cB + (size_t)(t + 2) * kstep;
            const char* a3 = a2 + kstep; const char* b3 = b2 + kstep;
            if (last && has_next) S.a_ready(nxt);
            PG8_LDB(B0, 0, 0); PG8_SCHED; PG8_LDA(At, 0, 0); PG8_STAGE(PG8_SA(1, 1), a1 + hstep, voffA);
            PG8_WAIT_L(8); PG8_BAR; PG8_WAIT_L(0); PG8_MMA(0, 0, At, B0); PG8_BAR; PG8_SCHED;
            PG8_LDB(B1, 0, 1); PG8_STAGE(PG8_SB(0, 0), b2, voffB);
            PG8_BAR; PG8_WAIT_L(0); PG8_MMA(0, 1, At, B1); PG8_BAR;
            PG8_LDA(At, 0, 1); PG8_STAGE(PG8_SA(0, 0), a2, voffA);
            PG8_BAR; PG8_WAIT_L(0); PG8_MMA(1, 0, At, B0); PG8_BAR; PG8_SCHED;
            PG8_STAGE(PG8_SB(0, 1), b2 + hstep, voffB);
            PG8_WAIT_V(6); PG8_BAR; PG8_MMA(1, 1, At, B1); PG8_BAR;
            PG8_LDB(B0, 1, 0); PG8_SCHED; PG8_LDA(At, 1, 0); PG8_STAGE(PG8_SA(0, 1), a2 + hstep, voffA);
            PG8_WAIT_L(8); PG8_BAR; PG8_WAIT_L(0); PG8_MMA(0, 0, At, B0); PG8_BAR; PG8_SCHED;
            PG8_LDB(B1, 1, 1); PG8_STAGE(PG8_SB(1, 0), b3, voffB);
            PG8_BAR; PG8_WAIT_L(0); PG8_MMA(0, 1, At, B1); PG8_BAR;
            PG8_LDA(At, 1, 1); PG8_STAGE(PG8_SA(1, 0), a3, voffA);
            PG8_BAR; PG8_WAIT_L(0); PG8_MMA(1, 0, At, B0); PG8_BAR; PG8_SCHED;
            PG8_STAGE(PG8_SB(1, 1), b3 + hstep, voffB);
            PG8_WAIT_V(6); PG8_BAR; PG8_MMA(1, 1, At, B1); PG8_BAR;
        }
        if constexpr (!Epi::AFTER_DRAIN) { E(acc, cur, wr, wc, fr, fq); S.done(cur); }
        if (!has_next) break;
        if (!Epi::HOOKS)
#pragma unroll
        for (int a = 0; a < 2; ++a)
#pragma unroll
            for (int b = 0; b < 2; ++b)
#pragma unroll
                for (int m = 0; m < 4; ++m)
#pragma unroll
                    for (int n = 0; n < 2; ++n) acc[a][b][m][n] = (f32x4){0.f, 0.f, 0.f, 0.f};
        cur = nxt; cA = nA; cB = nB; ++ui;
    }
    PG8_WAIT_V(0);
    if (wr == 0) PG8_BAR;
    PG8_BAR;
    if constexpr (Epi::AFTER_DRAIN) { E.fused(acc, cur, wr, wc, fr, fq, lds, wid, lane); S.done(cur); }
#undef PG8_SA
#undef PG8_SB
#undef PG8_STAGE
#undef PG8_LDA
#undef PG8_LDB
#undef PG8_MMA
#undef PG8_WAIT_V
#undef PG8_WAIT_L
#undef PG8_BAR
#undef PG8_SCHED
}
}

__device__ __forceinline__ void tr_item(const float* __restrict__ W, int ldw, int k0, int c0, bf16_t* WT, int ldt, int d0, int kd0, const float* __restrict__ kscale, LAS float* scr, int lane) {
#pragma unroll 8
    for (int i = 0; i < 32; ++i) { const int kk = 2 * i + (lane >> 5); float v = W[(size_t)(k0 + kk) * ldw + c0 + (lane & 31)]; if (kscale) v *= kscale[k0 + kk]; scr[kk * 33 + (lane & 31)] = v; }
    LDS_WAIT();
    const int c = lane & 7;
#pragma unroll
    for (int j = 0; j < 4; ++j) { const int n = (lane >> 3) + 8 * j; const LAS float* s = scr + (8 * c) * 33 + n;
        u32x4 o; o.x = cvt_pk_bf16(s[0], s[33]); o.y = cvt_pk_bf16(s[66], s[99]); o.z = cvt_pk_bf16(s[132], s[165]); o.w = cvt_pk_bf16(s[198], s[231]);
        *(u32x4*)(WT + (size_t)(d0 + n) * ldt + kd0 + 8 * c) = o; }
    LDS_WAIT();
}

__device__ __forceinline__ void phase0(const Params& p, LAS unsigned char* lds) {
    const int tid = threadIdx.x, lane = tid & 63, wave = tid >> 6, G = gridDim.x;
    const int gw = blockIdx.x * 8 + wave, NGW = G * 8;
    unsigned char* ws = p.ws;
    bf16_t* WIN = (bf16_t*)(ws + WS_WIN); bf16_t* WCAT = (bf16_t*)(ws + WS_WCAT); bf16_t* WOUT = (bf16_t*)(ws + WS_WOUT); bf16_t* PMIX = (bf16_t*)(ws + WS_PMIX);
    bf16_t* HB = (bf16_t*)(p.out + O_YP); float* DT = (float*)(ws + WS_DT);
    { float* z = (float*)(ws + WS_SSQ); for (int i = blockIdx.x * 512 + tid; i < 3 * MTOK; i += G * 512) z[i] = 0.f;
      if (blockIdx.x == 0 && tid == 0) *(unsigned*)(ws + WS_CTL) = 0u; }
    LAS float* wdt = (LAS float*)lds;
    for (int e = tid; e < 4096; e += 512) { const int k = e >> 2, j4 = e & 3; const f32x4 v = *(const f32x4*)(p.w_in + (size_t)k * DIN + 2560 + 4 * j4);
        wdt[(4 * j4 + 0) * 1024 + k] = v.x; wdt[(4 * j4 + 1) * 1024 + k] = v.y; wdt[(4 * j4 + 2) * 1024 + k] = v.z; wdt[(4 * j4 + 3) * 1024 + k] = v.w; }
    LAS float* scr = (LAS float*)(lds + 65536 + wave * 8448);
    constexpr int I_IN = 16 * 176, I_A = 16 * 32, I_B = 8 * 32, I_O = 16 * 32, I_P = 4 * 8, NIT = I_IN + I_A + I_B + I_O + I_P;
    for (int it = gw; it < NIT; it += NGW) {
        int r = it;
        if (r < I_IN) { const int kb = r / 176, nb = r % 176, d0 = 32 * nb, c0 = d0 + (d0 >= 2560 ? 16 : 0); tr_item(p.w_in, DIN, 64 * kb, c0, WIN, 1024, d0, 64 * kb, nullptr, scr, lane); continue; } r -= I_IN;
        if (r < I_A) { const int kb = r >> 5, nb = r & 31; tr_item(p.w_a, 1024, 64 * kb, 32 * nb, WCAT, KCAT, 32 * nb, 64 * kb, p.ssm_norm, scr, lane); continue; } r -= I_A;
        if (r < I_B) { const int kb = r >> 5, nb = r & 31; tr_item(p.w_b, 1024, 64 * kb, 32 * nb, WCAT, KCAT, 32 * nb, 1024 + 64 * kb, nullptr, scr, lane); continue; } r -= I_B;
        if (r < I_O) { const int kb = r >> 5, nb = r & 31; tr_item(p.w_out, 1024, 64 * kb, 32 * nb, WOUT, 1024, 32 * nb, 64 * kb, nullptr, scr, lane); continue; } r -= I_O;
        { const int k = r >> 3, kb = (r >> 2) & 1, nb = r & 3; tr_item(p.pool_mix + (size_t)k * 16384, 128, 64 * kb, 32 * nb, PMIX + (size_t)k * 16384, 128, 32 * nb, 64 * kb, nullptr, scr, lane); }
    }
    __syncthreads();
    const float dtb = p.dt_bias[lane & 15];
    for (int m = gw; m < MTOK; m += NGW) {
        const float* xrow = m < NTOK_P ? p.x_p + (size_t)m * DM : p.x_s + (size_t)(m - NTOK_P) * DM;
        f32x4 v[4]; float ss = 0.f;
#pragma unroll
        for (int j = 0; j < 4; ++j) { v[j] = ((const f32x4*)xrow)[lane + 64 * j]; ss += (v[j].x * v[j].x + v[j].y * v[j].y) + (v[j].z * v[j].z + v[j].w * v[j].w); }
        const float rstd = rsqrtf(wave_sum(ss) * (1.f / DM) + EPS);
        unsigned long long* o8 = (unsigned long long*)(HB + (size_t)m * DM);
#pragma unroll
        for (int j = 0; j < 4; ++j) { const f32x4 g4 = ((const f32x4*)p.norm_pre)[lane + 64 * j]; v[j] = v[j] * rstd * g4;
            o8[lane + 64 * j] = (unsigned long long)cvt_pk_bf16(v[j].x, v[j].y) | ((unsigned long long)cvt_pk_bf16(v[j].z, v[j].w) << 32); }
        float mine = 0.f;
#pragma unroll
        for (int jj = 0; jj < 16; ++jj) { float s = 0.f;
#pragma unroll
            for (int j = 0; j < 4; ++j) { const f32x4 w4 = *(const LAS f32x4*)(wdt + jj * 1024 + 4 * lane + 256 * j); s += (v[j].x * w4.x + v[j].y * w4.y) + (v[j].z * w4.z + v[j].w * w4.w); }
            s = wave_sum(s); if (lane == jj) mine = s; }
        if (lane < 16) { const float a = mine + dtb; DT[(size_t)m * 16 + lane] = a > 20.f ? a : log1pf(__expf(a)); }
    }
}

constexpr int PIT = 272;
constexpr int OFF_C = 0, OFF_B = 34816, OFF_BT = 69632, OFF_XT = 104448, OFF_H = 121856, OFF_SM = 139264, OFF_MISC = OFF_SM + 2048;
static_assert(OFF_MISC + 64 <= LDS_BYTES, "lds");

template <int NT> __device__ __forceinline__ void conv_pair(const bf16_t* __restrict__ colp, int tb, const float (&w)[4][2], const float (&bias)[2], float (&out)[NT][2]) {
    unsigned raw[NT + 3];
#pragma unroll
    for (int i = 0; i < NT + 3; ++i) raw[i] = (tb - 3 + i) >= 0 ? *(const unsigned*)(colp + (ptrdiff_t)(i - 3) * NPROJ) : 0u;
#pragma unroll
    for (int i = 0; i < NT; ++i) {
        float v0 = bias[0], v1 = bias[1];
#pragma unroll
        for (int k = 0; k < 4; ++k) { v0 += w[k][0] * bf_lo(raw[i + k]); v1 += w[k][1] * bf_hi(raw[i + k]); }
        out[i][0] = silu_f(v0); out[i][1] = silu_f(v1);
    }
}

__device__ __forceinline__ void ssd_prompt_item(const Params& p, LAS unsigned char* lds, int item) {
    const int tid = threadIdx.x, wid = __builtin_amdgcn_readfirstlane(tid >> 6), lane = tid & 63, r = lane & 15, q = lane >> 4;
    const int b = item >> 4, head = item & 15, g = head >> 3;
    const bf16_t* PROJ = (const bf16_t*)(p.ws + WS_PROJ); const float* DT = (const float*)(p.ws + WS_DT); float* SSQ = (float*)(p.ws + WS_SSQ);
    bf16_t* YCAT = (bf16_t*)(p.out + O_YP);
    const float a_h = -__expf(p.a_log[head]), Dh = p.d_skip[head];
    LAS float* dts = (LAS float*)(lds + OFF_SM); LAS float* acs = dts + 128; LAS float* wsd = dts + 256; LAS float* misc = dts + 384;
    const int xp = tid & 31, xseg = tid >> 5, bp = tid & 63, bseg = tid >> 6;
    const int chx = head * 64 + 2 * xp, chb = 1024 + g * 128 + 2 * bp, chc = 1280 + g * 128 + 2 * bp;
    float wx[4][2], wb[4][2], wcc[4][2], bx[2], bb[2], bc[2];
#pragma unroll
    for (int k = 0; k < 4; ++k)
#pragma unroll
        for (int e = 0; e < 2; ++e) { wx[k][e] = p.conv_w[k * CONVD + chx + e]; wb[k][e] = p.conv_w[k * CONVD + chb + e]; wcc[k][e] = p.conv_w[k * CONVD + chc + e]; }
#pragma unroll
    for (int e = 0; e < 2; ++e) { bx[e] = p.conv_b[chx + e]; bb[e] = p.conv_b[chb + e]; bc[e] = p.conv_b[chc + e]; }
    f32x4 hacc[4];
#pragma unroll
    for (int i = 0; i < 4; ++i) hacc[i] = (f32x4){0.f, 0.f, 0.f, 0.f};
    for (int i = tid; i < 17408 / 4; i += 512) ((LAS unsigned*)(lds + OFF_H))[i] = 0u;
    const size_t row00 = (size_t)b * SEQ;
    float dtn0 = 0.f, dtn1 = 0.f;
    if (wid == 0) { dtn0 = DT[(row00 + 2 * lane) * 16 + head]; dtn1 = DT[(row00 + 2 * lane + 1) * 16 + head]; }
    const int lt = wid, l0 = 16 * wid;
    for (int c = 0; c < SEQ / 128; ++c) {
        const size_t rowb = row00 + (size_t)c * 128;
        if (wid == 0) {
            const float d0 = dtn0, d1 = dtn1, v0 = d0 * a_h, v1 = d1 * a_h;
            if (c + 1 < SEQ / 128) { dtn0 = DT[(rowb + 128 + 2 * lane) * 16 + head]; dtn1 = DT[(rowb + 128 + 2 * lane + 1) * 16 + head]; }
            float x = v0 + v1;
#pragma unroll
            for (int o = 1; o < 64; o <<= 1) { const float t = __shfl_up(x, o); if (lane >= o) x += t; }
            const float tot = __shfl(x, 63), a1 = x, a0 = x - v1;
            dts[2 * lane] = d0; dts[2 * lane + 1] = d1; acs[2 * lane] = a0; acs[2 * lane + 1] = a1;
            wsd[2 * lane] = d0 * __expf(tot - a0); wsd[2 * lane + 1] = d1 * __expf(tot - a1);
            if (lane == 0) misc[0] = __expf(tot);
        }
        __syncthreads();
        {   float o[8][2];
            conv_pair<8>(PROJ + (rowb + xseg * 8) * NPROJ + C_XBC + chx, c * 128 + xseg * 8, wx, bx, o);
#pragma unroll
            for (int e = 0; e < 2; ++e) { u32x4 w; w.x = cvt_pk_bf16(o[0][e], o[1][e]); w.y = cvt_pk_bf16(o[2][e], o[3][e]); w.z = cvt_pk_bf16(o[4][e], o[5][e]); w.w = cvt_pk_bf16(o[6][e], o[7][e]);
                *(LAS u32x4*)(lds + OFF_XT + (2 * xp + e) * PIT + xseg * 16) = w; }
        }
        {   float o[16][2];
            conv_pair<16>(PROJ + (rowb + bseg * 16) * NPROJ + C_XBC + chb, c * 128 + bseg * 16, wb, bb, o);
#pragma unroll
            for (int i = 0; i < 16; ++i) *(LAS unsigned*)(lds + OFF_B + (bseg * 16 + i) * PIT + bp * 4) = cvt_pk_bf16(o[i][0], o[i][1]);
            float wv[16];
#pragma unroll
            for (int i = 0; i < 4; ++i) { const f32x4 t = *(const LAS f32x4*)(wsd + bseg * 16 + 4 * i); wv[4 * i] = t.x; wv[4 * i + 1] = t.y; wv[4 * i + 2] = t.z; wv[4 * i + 3] = t.w; }
#pragma unroll
            for (int e = 0; e < 2; ++e)
#pragma unroll
                for (int hh = 0; hh < 2; ++hh) { u32x4 w;
                    w.x = cvt_pk_bf16(o[8 * hh + 0][e] * wv[8 * hh + 0], o[8 * hh + 1][e] * wv[8 * hh + 1]); w.y = cvt_pk_bf16(o[8 * hh + 2][e] * wv[8 * hh + 2], o[8 * hh + 3][e] * wv[8 * hh + 3]);
                    w.z = cvt_pk_bf16(o[8 * hh + 4][e] * wv[8 * hh + 4], o[8 * hh + 5][e] * wv[8 * hh + 5]); w.w = cvt_pk_bf16(o[8 * hh + 6][e] * wv[8 * hh + 6], o[8 * hh + 7][e] * wv[8 * hh + 7]);
                    *(LAS u32x4*)(lds + OFF_BT + (2 * bp + e) * PIT + bseg * 32 + hh * 16) = w; }
        }
        {   float o[16][2];
            conv_pair<16>(PROJ + (rowb + bseg * 16) * NPROJ + C_XBC + chc, c * 128 + bseg * 16, wcc, bc, o);
#pragma unroll
            for (int i = 0; i < 16; ++i) *(LAS unsigned*)(lds + OFF_C + (bseg * 16 + i) * PIT + bp * 4) = cvt_pk_bf16(o[i][0], o[i][1]);
        }
        __syncthreads();
        bf16x8 cf[4];
#pragma unroll
        for (int kk = 0; kk < 4; ++kk) cf[kk] = *(const LAS bf16x8*)(lds + OFF_C + (l0 + r) * PIT + kk * 64 + q * 16);
        f32x4 gacc[8];
#pragma unroll
        for (int st = 0; st < 8; ++st) { gacc[st] = (f32x4){0.f, 0.f, 0.f, 0.f};
            if (st <= lt) {
#pragma unroll
                for (int kk = 0; kk < 4; ++kk) { const bf16x8 bf = *(const LAS bf16x8*)(lds + OFF_B + (16 * st + r) * PIT + kk * 64 + q * 16); gacc[st] = MFMA16(bf, cf[kk], gacc[st]); } } }
        __syncthreads();
        const float acl = acs[l0 + r];
#pragma unroll
        for (int st = 0; st < 8; ++st) {
            if (st <= (lt | 1)) { const int s0 = 16 * st + 4 * q; const f32x4 as = *(const LAS f32x4*)(acs + s0), ds = *(const LAS f32x4*)(dts + s0); float mv[4];
#pragma unroll
                for (int j = 0; j < 4; ++j) { const bool ok = (st <= lt) && (l0 + r >= s0 + j); mv[j] = ok ? gacc[st][j] * __expf(acl - as[j]) * ds[j] : 0.f; }
                u32x2 w; w.x = cvt_pk_bf16(mv[0], mv[1]); w.y = cvt_pk_bf16(mv[2], mv[3]);
                *(LAS u32x2*)(lds + OFF_B + (l0 + r) * PIT + s0 * 2) = w; } }
        __syncthreads();
        f32x4 yd[4], yo[4];
#pragma unroll
        for (int i = 0; i < 4; ++i) { yd[i] = (f32x4){0.f, 0.f, 0.f, 0.f}; yo[i] = (f32x4){0.f, 0.f, 0.f, 0.f}; }
        const int kmax = lt >> 1;
#pragma unroll
        for (int kk = 0; kk < 4; ++kk) {
            if (kk <= kmax) { const bf16x8 mf = *(const LAS bf16x8*)(lds + OFF_B + (l0 + r) * PIT + kk * 64 + q * 16);
#pragma unroll
                for (int pt = 0; pt < 4; ++pt) { const bf16x8 xf = *(const LAS bf16x8*)(lds + OFF_XT + (16 * pt + r) * PIT + kk * 64 + q * 16); yd[pt] = MFMA16(xf, mf, yd[pt]); } }
#pragma unroll
            for (int pt = 0; pt < 4; ++pt) { const bf16x8 hf = *(const LAS bf16x8*)(lds + OFF_H + (16 * pt + r) * PIT + kk * 64 + q * 16); yo[pt] = MFMA16(hf, cf[kk], yo[pt]); }
        }
        { const float eend = misc[0];
#pragma unroll
          for (int pt = 0; pt < 4; ++pt) hacc[pt] *= eend;
#pragma unroll
          for (int kk = 0; kk < 4; ++kk) { const bf16x8 btf = *(const LAS bf16x8*)(lds + OFF_BT + (16 * wid + r) * PIT + kk * 64 + q * 16);
#pragma unroll
              for (int pt = 0; pt < 4; ++pt) { const bf16x8 xf = *(const LAS bf16x8*)(lds + OFF_XT + (16 * pt + r) * PIT + kk * 64 + q * 16); hacc[pt] = MFMA16(btf, xf, hacc[pt]); } } }
        { const float el = __expf(acl); const size_t row = rowb + l0 + r; float ss = 0.f;
#pragma unroll
          for (int pt = 0; pt < 4; ++pt) { const int p0 = 16 * pt + 4 * q; const u32x2 z2 = *(const u32x2*)(PROJ + row * NPROJ + C_Z + head * 64 + p0); float y[4];
#pragma unroll
              for (int j = 0; j < 4; ++j) { const float xv = bf2f(*(const LAS bf16_t*)(lds + OFF_XT + (p0 + j) * PIT + (l0 + r) * 2));
                  const unsigned zw = (j < 2) ? z2.x : z2.y; const float zv = (j & 1) ? bf_hi(zw) : bf_lo(zw);
                  y[j] = (yd[pt][j] + el * yo[pt][j] + Dh * xv) * silu_f(zv); ss += y[j] * y[j]; }
              u32x2 w; w.x = cvt_pk_bf16(y[0], y[1]); w.y = cvt_pk_bf16(y[2], y[3]);
              *(u32x2*)(YCAT + row * KCAT + head * 64 + p0) = w; }
          ss += __shfl_xor(ss, 16); ss += __shfl_xor(ss, 32);
          if (q == 0) atomicAdd(SSQ + row * 2 + g, ss); }
        __syncthreads();
#pragma unroll
        for (int pt = 0; pt < 4; ++pt) { u32x2 w; w.x = cvt_pk_bf16(hacc[pt][0], hacc[pt][1]); w.y = cvt_pk_bf16(hacc[pt][2], hacc[pt][3]);
            *(LAS u32x2*)(lds + OFF_H + (16 * pt + r) * PIT + (16 * wid + 4 * q) * 2) = w; }
    }
    float* so = p.out + O_SSMP + ((size_t)(b * NH + head) * HD) * DS;
#pragma unroll
    for (int pt = 0; pt < 4; ++pt) *(f32x4*)(so + (size_t)(16 * pt + r) * DS + 16 * wid + 4 * q) = hacc[pt];
}

__device__ __forceinline__ void pool_item(const Params& p, LAS unsigned char* lds, int j) {
    const int tid = threadIdx.x, wid = __builtin_amdgcn_readfirstlane(tid >> 6), lane = tid & 63, r = lane & 15, q = lane >> 4;
    const bf16_t* PROJ = (const bf16_t*)(p.ws + WS_PROJ); const bf16_t* PMIX = (const bf16_t*)(p.ws + WS_PMIX); bf16_t* YCAT = (bf16_t*)(p.out + O_YP);
    const int row0 = 128 * j; const bool prompt = row0 < NTOK_P;
    const int cp = tid & 63, ts0 = (tid >> 6) * 16;
    for (int k = 0; k < 4; ++k) {
        const int W = 2 << k; const float invW = 1.f / (float)W;
        const bf16_t* ucol = PROJ + C_U + k * 128 + 2 * cp;
        if (prompt) {
            const int tb = (row0 & (SEQ - 1)) + ts0; const size_t rw = (size_t)row0 + ts0;
            float r0 = 0.f, r1 = 0.f;
            for (int jb = 1; jb < W; ++jb) if (tb - jb >= 0) { const unsigned u = *(const unsigned*)(ucol + (rw - jb) * NPROJ); r0 += bf_lo(u); r1 += bf_hi(u); }
#pragma unroll 4
            for (int i = 0; i < 16; ++i) { const unsigned u = *(const unsigned*)(ucol + (rw + i) * NPROJ); const float c0 = bf_lo(u), c1 = bf_hi(u); r0 += c0; r1 += c1;
                const int cnt = min(tb + i + 1, W); const float ic = 1.f / (float)cnt;
                *(LAS unsigned*)(lds + (ts0 + i) * PIT + cp * 4) = cvt_pk_bf16(r0 * ic - c0, r1 * ic - c1);
                if (tb + i - W + 1 >= 0) { const unsigned uo = *(const unsigned*)(ucol + (rw + i - W + 1) * NPROJ); r0 -= bf_lo(uo); r1 -= bf_hi(uo); } }
        } else {
            for (int i = 0; i < 16; ++i) { const int row = row0 + ts0 + i, sidx = row - NTOK_P, bb = sidx >> 3, t = sidx & 7; float s0 = 0.f, s1 = 0.f, c0 = 0.f, c1 = 0.f;
                for (int jb = 0; jb < W; ++jb) { const int e = t - jb; float v0, v1;
                    if (e >= 0) { const unsigned u = *(const unsigned*)(ucol + (size_t)(row - jb) * NPROJ); v0 = bf_lo(u); v1 = bf_hi(u); }
                    else { const f32x2 sv = *(const f32x2*)(p.st_pool + ((size_t)bb * 15 + 15 + e) * DPOOL + k * 128 + 2 * cp); v0 = sv.x; v1 = sv.y; }
                    if (jb == 0) { c0 = v0; c1 = v1; } s0 += v0; s1 += v1; }
                *(LAS unsigned*)(lds + (ts0 + i) * PIT + cp * 4) = cvt_pk_bf16(s0 * invW - c0, s1 * invW - c1); }
        }
        __syncthreads();
        bf16x8 mf[4];
#pragma unroll
        for (int kk = 0; kk < 4; ++kk) mf[kk] = *(const bf16x8*)(PMIX + ((size_t)k * 128 + 16 * wid + r) * 128 + kk * 32 + q * 8);
        const int d0 = k * 128 + 16 * wid + 4 * q; const f32x4 sc = *(const f32x4*)(p.pool_scale + d0);
#pragma unroll 2
        for (int tt = 0; tt < 8; ++tt) { f32x4 acc = (f32x4){0.f, 0.f, 0.f, 0.f};
#pragma unroll
            for (int kk = 0; kk < 4; ++kk) { const bf16x8 af = *(const LAS bf16x8*)(lds + (16 * tt + r) * PIT + kk * 64 + q * 16); acc = MFMA16(mf[kk], af, acc); }
            const size_t row = (size_t)row0 + 16 * tt + r; const u32x2 g2 = *(const u32x2*)(PROJ + row * NPROJ + C_G + d0);
            const float y0 = acc[0] * sc.x * silu_f(bf_lo(g2.x)), y1 = acc[1] * sc.y * silu_f(bf_hi(g2.x)), y2 = acc[2] * sc.z * silu_f(bf_lo(g2.y)), y3 = acc[3] * sc.w * silu_f(bf_hi(g2.y));
            u32x2 w; w.x = cvt_pk_bf16(y0, y1); w.y = cvt_pk_bf16(y2, y3);
            *(u32x2*)(YCAT + row * KCAT + 1024 + d0) = w; }
        __syncthreads();
    }
}

__device__ __forceinline__ void ssd_sample_item(const Params& p, LAS unsigned char* lds, int it) {
    const int tid = threadIdx.x, lane = tid & 63;
    const int b = it >> 4, head = it & 15, g = head >> 3;
    const bf16_t* PROJ = (const bf16_t*)(p.ws + WS_PROJ); const float* DT = (const float*)(p.ws + WS_DT); float* SSQ = (float*)(p.ws + WS_SSQ); bf16_t* YCAT = (bf16_t*)(p.out + O_YP);
    LAS float* xs = (LAS float*)lds; LAS float* Bs = xs + 512; LAS float* Cs = Bs + 1024; LAS float* Gs = Cs + 1024; LAS float* yo = Gs + 64; LAS float* sdt = yo + 512; LAS float* sac = sdt + 8;
    const size_t row0 = (size_t)NTOK_P + (size_t)b * LS;
    for (int e = tid; e < 2560; e += 512) { const int t = e / 320, c = e % 320;
        const int ch = c < 64 ? head * 64 + c : (c < 192 ? 1024 + g * 128 + (c - 64) : 1280 + g * 128 + (c - 192));
        float v = p.conv_b[ch];
#pragma unroll
        for (int k = 0; k < 4; ++k) { const int ei = t + k;
            const float val = ei < 3 ? p.st_conv[((size_t)b * 3 + ei) * CONVD + ch] : bf2f(PROJ[(row0 + ei - 3) * NPROJ + C_XBC + ch]);
            v += val * p.conv_w[k * CONVD + ch]; }
        v = silu_f(v);
        if (c < 64) xs[t * 64 + c] = v; else if (c < 192) Bs[t * 128 + c - 64] = v; else Cs[t * 128 + c - 192] = v; }
    const float a_h = -__expf(p.a_log[head]), Dh = p.d_skip[head];
    float dt[8], ac[8]; { float run = 0.f;
#pragma unroll
        for (int t = 0; t < 8; ++t) { dt[t] = DT[(row0 + t) * 16 + head]; run += dt[t] * a_h; ac[t] = run; } }
    if (tid < 8) { float dsel = 0.f, asel = 0.f;
#pragma unroll
        for (int t = 0; t < 8; ++t) if (tid == t) { dsel = dt[t]; asel = ac[t]; }
        sdt[tid] = dsel; sac[tid] = asel; }
    const int n4 = tid & 31, prow = tid >> 5;
    const float* hin = p.st_ssm + ((size_t)(b * NH + head) * HD) * DS; float* hout = p.out + O_SSMS + ((size_t)(b * NH + head) * HD) * DS;
    f32x4 h[4];
#pragma unroll
    for (int i = 0; i < 4; ++i) h[i] = *(const f32x4*)(hin + (size_t)(prow + 16 * i) * DS + 4 * n4);
    __syncthreads();
    if (tid < 64) { const int l = tid >> 3, s = tid & 7; float acc = 0.f;
        for (int n = 0; n < 128; n += 4) { const f32x4 cv = *(const LAS f32x4*)(Cs + l * 128 + n), bv = *(const LAS f32x4*)(Bs + s * 128 + n); acc += (cv.x * bv.x + cv.y * bv.y) + (cv.z * bv.z + cv.w * bv.w); }
        Gs[tid] = acc; }
    {   float part[8][4];
#pragma unroll
        for (int l = 0; l < 8; ++l) { const f32x4 cv = *(const LAS f32x4*)(Cs + l * 128 + 4 * n4);
#pragma unroll
            for (int i = 0; i < 4; ++i) part[l][i] = (cv.x * h[i].x + cv.y * h[i].y) + (cv.z * h[i].z + cv.w * h[i].w); }
#pragma unroll
        for (int o = 1; o < 32; o <<= 1)
#pragma unroll
            for (int l = 0; l < 8; ++l)
#pragma unroll
                for (int i = 0; i < 4; ++i) part[l][i] += __shfl_xor(part[l][i], o);
        if (n4 == 0) {
#pragma unroll
            for (int l = 0; l < 8; ++l)
#pragma unroll
                for (int i = 0; i < 4; ++i) yo[l * 64 + prow + 16 * i] = part[l][i]; }
    }
    {   const float eend = __expf(ac[7]); f32x4 hn[4];
#pragma unroll
        for (int i = 0; i < 4; ++i) hn[i] = h[i] * eend;
#pragma unroll
        for (int s = 0; s < 8; ++s) { const float w = dt[s] * __expf(ac[7] - ac[s]); const f32x4 bv = *(const LAS f32x4*)(Bs + s * 128 + 4 * n4);
#pragma unroll
            for (int i = 0; i < 4; ++i) { const float xv = xs[s * 64 + prow + 16 * i] * w; hn[i] += bv * xv; } }
#pragma unroll
        for (int i = 0; i < 4; ++i) *(f32x4*)(hout + (size_t)(prow + 16 * i) * DS + 4 * n4) = hn[i];
    }
    __syncthreads();
    {   const int l = tid >> 6, pp = lane; const float al = sac[l];
        float y = __expf(al) * yo[l * 64 + pp];
        for (int s = 0; s <= l; ++s) y += Gs[l * 8 + s] * __expf(al - sac[s]) * sdt[s] * xs[s * 64 + pp];
        y += Dh * xs[l * 64 + pp];
        const float zv = bf2f(PROJ[(row0 + l) * NPROJ + C_Z + head * 64 + pp]);
        y *= silu_f(zv);
        const float ss = wave_sum(y * y);
        if (lane == 0) atomicAdd(SSQ + (row0 + l) * 2 + g, ss);
        YCAT[(row0 + l) * KCAT + head * 64 + pp] = (bf16_t)(cvt_pk_bf16(y, 0.f) & 0xffffu);
    }
    __syncthreads();
}

constexpr int E_CP = NB_P * 3 * CONVD, E_PP = NB_P * 15 * DPOOL, E_CS = NB_S * 3 * CONVD, E_PS = NB_S * 15 * DPOOL, E_ALL = E_CP + E_PP + E_CS + E_PS, N_COPY = 64;
__device__ __forceinline__ void copy_item(const Params& p, int it) {
    const bf16_t* PROJ = (const bf16_t*)(p.ws + WS_PROJ);
    constexpr int PER = E_ALL / N_COPY; static_assert(E_ALL % N_COPY == 0, "copy split");
    for (int e = it * PER + threadIdx.x; e < (it + 1) * PER; e += 512) {
        int r = e;
        if (r < E_CP) { const int b = r / (3 * CONVD), rem = r % (3 * CONVD), j = rem / CONVD, ch = rem % CONVD; p.out[O_CONVP + r] = bf2f(PROJ[((size_t)b * SEQ + SEQ - 3 + j) * NPROJ + C_XBC + ch]); continue; } r -= E_CP;
        if (r < E_PP) { const int b = r / (15 * DPOOL), rem = r % (15 * DPOOL), j = rem / DPOOL, ch = rem % DPOOL; p.out[O_POOLP + r] = bf2f(PROJ[((size_t)b * SEQ + SEQ - 15 + j) * NPROJ + C_U + ch]); continue; } r -= E_PP;
        if (r < E_CS) { const int b = r / (3 * CONVD), rem = r % (3 * CONVD), j = rem / CONVD, ch = rem % CONVD; p.out[O_CONVS + r] = bf2f(PROJ[((size_t)NTOK_P + b * LS + LS - 3 + j) * NPROJ + C_XBC + ch]); continue; } r -= E_CS;
        { const int b = r / (15 * DPOOL), rem = r % (15 * DPOOL), j = rem / DPOOL, ch = rem % DPOOL;
          p.out[O_POOLS + r] = j < 7 ? p.st_pool[((size_t)b * 15 + 8 + j) * DPOOL + ch] : bf2f(PROJ[((size_t)NTOK_P + b * LS + (j - 7)) * NPROJ + C_U + ch]); }
    }
}

constexpr int IT_SSD = NB_P * NH, IT_POOL = MTOK / 128, IT_SMP = NB_S * NH, IT_ALL = IT_SSD + IT_POOL + IT_SMP + N_COPY;
__device__ __forceinline__ void phase2(const Params& p, LAS unsigned char* lds) {
    unsigned* ctr = (unsigned*)(p.ws + WS_CTL);
    volatile LAS int* slot = (volatile LAS int*)(lds + OFF_MISC);
    for (;;) {
        __syncthreads();
        if (threadIdx.x == 0) slot[0] = (int)atomicAdd(ctr, 1u);
        __syncthreads();
        const int it = slot[0];
        if (it >= IT_ALL) break;
        if (it < IT_SSD) ssd_prompt_item(p, lds, it);
        else if (it < IT_SSD + IT_POOL) pool_item(p, lds, it - IT_SSD);
        else if (it < IT_SSD + IT_POOL + IT_SMP) ssd_sample_item(p, lds, it - IT_SSD - IT_POOL);
        else copy_item(p, it - IT_SSD - IT_POOL - IT_SMP);
    }
}

__device__ __forceinline__ void phase5(const Params& p) {
    const int tid = threadIdx.x, lane = tid & 63, wave = tid >> 6; const int gw = blockIdx.x * 8 + wave, NGW = gridDim.x * 8;
    const bf16_t* OUTB = (const bf16_t*)(p.ws + WS_PROJ); const float* SSQ2 = (const float*)(p.ws + WS_SSQ2);
    for (int m = gw; m < MTOK; m += NGW) {
        const float* xrow = m < NTOK_P ? p.x_p + (size_t)m * DM : p.x_s + (size_t)(m - NTOK_P) * DM;
        float* yrow = m < NTOK_P ? p.out + O_YP + (size_t)m * DM : p.out + O_YS + (size_t)(m - NTOK_P) * DM;
        const float rstd = rsqrtf(SSQ2[m] * (1.f / DM) + EPS);
#pragma unroll
        for (int j = 0; j < 4; ++j) { const f32x4 x4 = ((const f32x4*)xrow)[lane + 64 * j], g4 = ((const f32x4*)p.norm_post)[lane + 64 * j]; const u32x2 o2 = ((const u32x2*)(OUTB + (size_t)m * DM))[lane + 64 * j];
            f32x4 y; y.x = x4.x + bf_lo(o2.x) * rstd * g4.x; y.y = x4.y + bf_hi(o2.x) * rstd * g4.y; y.z = x4.z + bf_lo(o2.y) * rstd * g4.z; y.w = x4.w + bf_hi(o2.y) * rstd * g4.w;
            ((f32x4*)yrow)[lane + 64 * j] = y; }
    }
}

__global__ void __launch_bounds__(512, 2) fwd_kernel(Params p) {
    extern __shared__ __attribute__((aligned(16))) unsigned char smem[];
    LAS unsigned char* lds = (LAS unsigned char*)smem;
    cg::grid_group grid = cg::this_grid();
    unsigned char* ws = p.ws;
    const int lo = p.ph_lo, hi = p.ph_hi;
#define IN(k) (lo <= (k) && (k) < hi)
#define SEAM(k) do { if (IN(k) && IN((k) + 1)) grid.sync(); } while (0)
    if (IN(0)) phase0(p, lds);
    SEAM(0);
    if (IN(1)) { pg8::Gemm g{(const bf16_t*)(p.out + O_YP), (const bf16_t*)(ws + WS_WIN), MTOK, NPROJ, DM}; pg8::StaticOrder S; S.init(MTOK, NPROJ, (int)gridDim.x, (int)blockIdx.x);
        pg8::EpiStore E{(bf16_t*)(ws + WS_PROJ), NPROJ}; pg8::gemm_phase<pg8::EpiStore, pg8::StaticOrder>(lds, g, S, E); }
    SEAM(1);
    if (IN(2)) phase2(p, lds);
    SEAM(2);
    if (IN(3)) { pg8::Gemm g{(const bf16_t*)(p.out + O_YP), (const bf16_t*)(ws + WS_WCAT), MTOK, DM, KCAT}; pg8::SegOrder S; S.init(MTOK, DM, (int)gridDim.x, (int)blockIdx.x);
        pg8::EpiMerge E{(const bf16_t*)(ws + WS_PROJ), (const float*)(ws + WS_SSQ), (bf16_t*)(ws + WS_MERGED)}; pg8::gemm_phase<pg8::EpiMerge, pg8::SegOrder>(lds, g, S, E); }
    SEAM(3);
    if (IN(4)) { pg8::Gemm g{(const bf16_t*)(ws + WS_MERGED), (const bf16_t*)(ws + WS_WOUT), MTOK, DM, DM}; pg8::StaticOrder S; S.init(MTOK, DM, (int)gridDim.x, (int)blockIdx.x);
        pg8::EpiOut E{(bf16_t*)(ws + WS_PROJ), (float*)(ws + WS_SSQ2)}; pg8::gemm_phase<pg8::EpiOut, pg8::StaticOrder>(lds, g, S, E); }
    SEAM(4);
    if (IN(5)) phase5(p);
}

#ifndef N_LAUNCH_MODE
#define N_LAUNCH_MODE 1
#endif
extern "C" void kernel_launch(void* const* d_in, const int* in_sizes, int n_in, void* d_out, int out_size, void* d_ws, size_t ws_size, hipStream_t stream) {
    static int grid = 0;
    if (grid == 0) {
        if (n_in != 19 || (size_t)out_size != O_END || ws_size < WS_END) { fprintf(stderr, "kernel_launch: unexpected sizes n_in %d out %d ws %zu (need %zu)\n", n_in, out_size, ws_size, (size_t)WS_END); grid = -1; return; }
        int dev = 0, cus = 0, per_cu = 0;
        hipGetDevice(&dev); hipDeviceGetAttribute(&cus, hipDeviceAttributeMultiprocessorCount, dev);
        if (hipFuncSetAttribute((const void*)fwd_kernel, hipFuncAttributeMaxDynamicSharedMemorySize, LDS_BYTES) != hipSuccess) { fprintf(stderr, "kernel_launch: hipFuncSetAttribute failed\n"); grid = -1; return; }
        if (hipOccupancyMaxActiveBlocksPerMultiprocessor(&per_cu, (const void*)fwd_kernel, 512, LDS_BYTES) != hipSuccess || per_cu < 1) { fprintf(stderr, "kernel_launch: occupancy query failed (%d)\n", per_cu); grid = -1; return; }
        grid = cus;
    }
    if (grid <= 0) return;
    Params p{};
    const float** f = (const float**)&p;
    for (int i = 0; i < 19; ++i) f[i] = (const float*)d_in[i];
    p.out = (float*)d_out; p.ws = (unsigned char*)d_ws;
    if (N_LAUNCH_MODE == 1) {
        p.ph_lo = 0; p.ph_hi = 6; void* args[] = {&p};
        hipError_t e = hipLaunchCooperativeKernel((const void*)fwd_kernel, dim3(grid), dim3(512), args, LDS_BYTES, stream);
        if (e != hipSuccess) fprintf(stderr, "cooperative launch failed: %s (grid %d)\n", hipGetErrorString(e), grid);
    } else {
        for (int ph = 0; ph < 6; ++ph) { p.ph_lo = ph; p.ph_hi = ph + 1; hipLaunchKernelGGL(fwd_kernel, dim3(grid), dim3(512), LDS_BYTES, stream, p); }
    }
}
```

```cpp
#include <hip/hip_runtime.h>
#include <hip/hip_cooperative_groups.h>
#include <cstdio>
#include <cstdint>
namespace cg = cooperative_groups;

#define LAS __attribute__((address_space(3)))
typedef unsigned short bf16_t;
typedef short bf16x8 __attribute__((ext_vector_type(8)));
typedef float f32x4 __attribute__((ext_vector_type(4)));
typedef float f32x2 __attribute__((ext_vector_type(2)));
typedef unsigned u32x4 __attribute__((ext_vector_type(4)));
typedef unsigned u32x2 __attribute__((ext_vector_type(2)));

constexpr int DM = 1024, SEQ = 2048, NB_P = 8, NB_S = 128, LS = 8;
constexpr int NTOK_P = NB_P * SEQ, NTOK_S = NB_S * LS, MTOK = NTOK_P + NTOK_S;
constexpr int NPROJ = 5632;
constexpr int C_Z = 0, C_XBC = 1024, C_U = 2560, C_G = 3072, C_GATE = 3584;
constexpr int DIN = 5648, CONVD = 1536, NH = 16, HD = 64, DS = 128, DPOOL = 512, KCAT = 1536;
constexpr float EPS = 1e-6f;

constexpr size_t WS_CTL = 0;
constexpr size_t WS_BAR = 4096;
constexpr size_t WS_SSQ = 4096 + 16384;
constexpr size_t WS_SSQ2 = WS_SSQ + (size_t)MTOK * 2 * 4;
constexpr size_t WS_DT = WS_SSQ2 + (size_t)MTOK * 4;
constexpr size_t WS_WIN = (WS_DT + (size_t)MTOK * 16 * 4 + 255) / 256 * 256;
constexpr size_t WS_WCAT = WS_WIN + (size_t)NPROJ * DM * 2;
constexpr size_t WS_WOUT = WS_WCAT + (size_t)DM * KCAT * 2;
constexpr size_t WS_PMIX = WS_WOUT + (size_t)DM * DM * 2;
constexpr size_t WS_PROJ = WS_PMIX + (size_t)4 * 128 * 128 * 2;
constexpr size_t WS_X = WS_PROJ + (size_t)MTOK * NPROJ * 2;
constexpr size_t WS_MERGED = WS_X;
constexpr size_t WS_END = WS_X + (size_t)MTOK * KCAT * 2;
static_assert(WS_END <= (size_t)256 * 1024 * 1024, "d_ws is only guaranteed to be 256 MiB");

constexpr size_t O_YP = 0, O_YS = O_YP + (size_t)NTOK_P * DM, O_CONVP = O_YS + (size_t)NTOK_S * DM, O_SSMP = O_CONVP + (size_t)NB_P * 3 * CONVD,
                 O_POOLP = O_SSMP + (size_t)NB_P * NH * HD * DS, O_CONVS = O_POOLP + (size_t)NB_P * 15 * DPOOL, O_SSMS = O_CONVS + (size_t)NB_S * 3 * CONVD,
                 O_POOLS = O_SSMS + (size_t)NB_S * NH * HD * DS, O_END = O_POOLS + (size_t)NB_S * 15 * DPOOL;

constexpr int LDS_BYTES = 147456;

struct Params {
    const float *x_p, *x_s, *st_conv, *st_ssm, *st_pool, *norm_pre, *w_in, *conv_w, *conv_b, *dt_bias, *a_log, *d_skip, *ssm_norm, *w_a, *pool_mix, *pool_scale, *w_b, *w_out, *norm_post;
    float* out; unsigned char* ws; int ph_lo, ph_hi;
};

__device__ __forceinline__ unsigned cvt_pk_bf16(float lo, float hi) { unsigned r; asm("v_cvt_pk_bf16_f32 %0, %1, %2" : "=v"(r) : "v"(lo), "v"(hi)); return r; }
__device__ __forceinline__ float bf_lo(unsigned u) { return __uint_as_float(u << 16); }
__device__ __forceinline__ float bf_hi(unsigned u) { return __uint_as_float(u & 0xffff0000u); }
__device__ __forceinline__ float bf2f(bf16_t v) { return __uint_as_float((unsigned)v << 16); }
__device__ __forceinline__ float silu_f(float v) { return v * __builtin_amdgcn_rcpf(1.f + __expf(-v)); }
__device__ __forceinline__ float wave_sum(float v) {
#pragma unroll
    for (int o = 1; o < 64; o <<= 1) v += __shfl_xor(v, o);
    return v;
}
#define LDS_WAIT() asm volatile("s_waitcnt lgkmcnt(0)" ::: "memory")
#define MFMA16(a, b, c) __builtin_amdgcn_mfma_f32_16x16x32_bf16((a), (b), (c), 0, 0, 0)

namespace pg8 {
#define PG8_LAS __attribute__((address_space(3)))
typedef unsigned short bf16_t;
typedef short bf16x8 __attribute__((ext_vector_type(8)));
typedef float f32x4 __attribute__((ext_vector_type(4)));
typedef unsigned u32x4 __attribute__((ext_vector_type(4)));
constexpr int BM = 256, BK = 64, HALF = 128, HTB = HALF * BK * 2  , STAGE_BYTES = 8 * HTB, NXCD = 8, WGM = 8;

__host__ __device__ __forceinline__ int lds_byte(int r, int c) { const int st = (r >> 4) * 2 + (c >> 5), rr = r & 15, cc = c & 31, ob = rr * 64 + cc * 2; return st * 1024 + (ob ^ (((ob >> 9) & 1) << 5)); }
__host__ __device__ __forceinline__ void stage_rc(int b, int& R, int& C) { const int st = b / 1024, sb = b % 1024, swz = sb ^ (((sb >> 9) & 1) << 5); R = (st >> 1) * 16 + swz / 64; C = (st & 1) * 32 + (swz % 64) / 2; }
__host__ __device__ __forceinline__ int perm32(int rho) { const int n = rho >> 4, i = rho & 15; return 8 * (i >> 2) + 4 * n + (i & 3); }

struct Unit { int pm, pn, seg; };
struct Gemm { const bf16_t* A; const bf16_t* Bt; int M, N, K; };

struct StaticOrder {
    int nM, nN, nwg, G, c;
    __host__ __device__ void init(int M, int N, int G_, int c_) { nM = M / BM; nN = N / BM; nwg = nM * nN; G = G_; c = c_; }
    __host__ __device__ bool next(int i, Unit& u) const {
        const long L = (long)i * G + c; if (L >= nwg) return false;
        int wgid = (int)L; { const int q = nwg / NXCD, r = nwg % NXCD, xcd = wgid % NXCD, off = wgid / NXCD; wgid = (xcd < r ? xcd * (q + 1) : r * (q + 1) + (xcd - r) * q) + off; }
        const int nig = WGM * nN, gid = wgid / nig, fm = gid * WGM, gsz = (nM - fm) < WGM ? (nM - fm) : WGM;
        u.pm = fm + ((wgid % nig) % gsz); u.pn = (wgid % nig) / gsz; u.seg = 0; return true;
    }
    __device__ __forceinline__ void a_ready(const Unit&) const {}
    __device__ __forceinline__ void done(const Unit&) const {}
};

struct SegOrder : StaticOrder {
    __host__ __device__ bool next(int i, Unit& u) const { const bool ok = StaticOrder::next(i / 3, u); u.seg = i % 3; return ok; }
};

struct EpiStore {
    static constexpr bool PERM = true, AFTER_DRAIN = false, HOOKS = false;
    bf16_t* O; int ldc;
    __device__ __forceinline__ void operator()(const f32x4 (&acc)[2][2][4][2], const Unit& u, int wr, int wc, int fr, int fq) const {
        const int row0 = u.pm * BM + wr * 64 + fr, col0 = u.pn * BM + wc * 32 + 8 * fq;
#pragma unroll
        for (int ai = 0; ai < 2; ++ai)
#pragma unroll
            for (int m = 0; m < 4; ++m) { bf16_t* rowp = O + (size_t)(row0 + ai * HALF + m * 16) * ldc + col0;
#pragma unroll
                for (int bj = 0; bj < 2; ++bj) { const f32x4 v0 = acc[ai][bj][m][0], v1 = acc[ai][bj][m][1];
                    u32x4 w; w.x = ::cvt_pk_bf16(v0[0], v0[1]); w.y = ::cvt_pk_bf16(v0[2], v0[3]); w.z = ::cvt_pk_bf16(v1[0], v1[1]); w.w = ::cvt_pk_bf16(v1[2], v1[3]);
                    *(u32x4*)(rowp + bj * HALF) = w; } }
    }
};
struct EpiMerge {
    static constexpr bool PERM = true, AFTER_DRAIN = false, HOOKS = true;
    const bf16_t* proj; const float* ssq; bf16_t* O;
    __device__ __forceinline__ void operator()(f32x4 (&acc)[2][2][4][2], const Unit& u, int wr, int wc, int fr, int fq) const {
        int row0 = u.pm * BM + wr * 64 + fr, col0 = u.pn * BM + wc * 32 + 8 * fq;
        asm volatile("" : "+v"(row0), "+v"(col0));
        const char* pb = (const char*)proj; const int seg = u.seg;
        u32x4 rga[4], rgb[4];
#define EM_ROW(g) (row0 + ((g) >> 3) * HALF + (((g) >> 1) & 3) * 16)
#define EM_LOAD(g) do { const unsigned goff_ = ((unsigned)EM_ROW(g) * (unsigned)::NPROJ + (unsigned)(::C_GATE + col0)) * 2u + ((g) & 1) * 256; \
            rgb[(g) & 3] = *(const u32x4*)(pb + goff_ + 2048); if (seg == 1) rga[(g) & 3] = *(const u32x4*)(pb + goff_); } while (0)
#pragma unroll
        for (int g = 0; g < 4; ++g) { rga[g] = (u32x4){0u, 0u, 0u, 0u}; rgb[g] = (u32x4){0u, 0u, 0u, 0u}; }
        if (seg != 0) {
#pragma unroll
            for (int g = 0; g < 4; ++g) EM_LOAD(g); }
        ::f32x2 sq[8];
#pragma unroll
        for (int h = 0; h < 8; ++h) sq[h] = (::f32x2){1.f, 1.f};
        if (seg != 2) {
#pragma unroll
            for (int h = 0; h < 8; ++h) sq[h] = *(const ::f32x2*)((const char*)ssq + (unsigned)EM_ROW(2 * h) * 8u); }
#pragma unroll
        for (int g = 0; g < 16; ++g) { const int ai = g >> 3, m = (g >> 1) & 3, bj = g & 1; const int row = EM_ROW(g);
            const ::f32x2 s = sq[g >> 1]; const float q1 = s.y * (1.f / 512.f) + ::EPS, r1 = rsqrtf(q1), rr = rsqrtf(s.x * (1.f / 512.f) + ::EPS) * __builtin_amdgcn_sqrtf(q1);
            const u32x4 ga = rga[g & 3], gb = rgb[g & 3]; float v[8];
#pragma unroll
            for (int idx = 0; idx < 8; ++idx) { const unsigned wa = ga[idx >> 1], wb = gb[idx >> 1];
                const float va = (idx & 1) ? ::bf_hi(wa) : ::bf_lo(wa), vb = (idx & 1) ? ::bf_hi(wb) : ::bf_lo(wb);
                const float ea = 1.f + __expf(-va), eb = 1.f + __expf(-vb);
                const float f = seg == 0 ? rr : (seg == 1 ? r1 * eb * __builtin_amdgcn_rcpf(ea) : __builtin_amdgcn_rcpf(eb));
                v[idx] = acc[ai][bj][m][idx >> 2][idx & 3] * f; }
            if (seg == 2) { u32x4 w; w.x = ::cvt_pk_bf16(v[0], v[1]); w.y = ::cvt_pk_bf16(v[2], v[3]); w.z = ::cvt_pk_bf16(v[4], v[5]); w.w = ::cvt_pk_bf16(v[6], v[7]);
                *(u32x4*)((char*)O + ((unsigned)row * (unsigned)::DM + (unsigned)col0) * 2u + bj * 256) = w; }
            const float keep = seg == 2 ? 0.f : 1.f;
            acc[ai][bj][m][0] = (f32x4){v[0], v[1], v[2], v[3]} * keep; acc[ai][bj][m][1] = (f32x4){v[4], v[5], v[6], v[7]} * keep;
            if (g + 4 < 16 && seg != 0) EM_LOAD(g + 4);
            asm volatile("" : "+v"(acc[ai][bj][m][0]), "+v"(acc[ai][bj][m][1]) :: "memory"); }
#undef EM_LOAD
#undef EM_ROW
    }
};
struct EpiOut {
    static constexpr bool PERM = true, AFTER_DRAIN = false, HOOKS = false;
    bf16_t* O; float* ssq2; float scale;
    __device__ __forceinline__ void operator()(const f32x4 (&acc)[2][2][4][2], const Unit& u, int wr, int wc, int fr, int fq) const {
        const int row0 = u.pm * BM + wr * 64 + fr, col0 = u.pn * BM + wc * 32 + 8 * fq;
#pragma unroll
        for (int ai = 0; ai < 2; ++ai)
#pragma unroll
            for (int m = 0; m < 4; ++m) { const int row = row0 + ai * HALF + m * 16; float ss = 0.f;
#pragma unroll
                for (int bj = 0; bj < 2; ++bj) { const f32x4 v0 = acc[ai][bj][m][0], v1 = acc[ai][bj][m][1];
                    ss += (v0[0] * v0[0] + v0[1] * v0[1]) + (v0[2] * v0[2] + v0[3] * v0[3]) + (v1[0] * v1[0] + v1[1] * v1[1]) + (v1[2] * v1[2] + v1[3] * v1[3]);
                    u32x4 w; w.x = ::cvt_pk_bf16(v0[0], v0[1]); w.y = ::cvt_pk_bf16(v0[2], v0[3]); w.z = ::cvt_pk_bf16(v1[0], v1[1]); w.w = ::cvt_pk_bf16(v1[2], v1[3]);
                    *(u32x4*)(O + (size_t)row * ::DM + col0 + bj * HALF) = w; }
                ss += __shfl_xor(ss, 16); ss += __shfl_xor(ss, 32);
                if (fq == 0) atomicAdd(ssq2 + row, ss * scale); }
    }
};

template <class Epi, class Sched>
__device__ __forceinline__ void gemm_phase(PG8_LAS unsigned char* lds, const Gemm g, const Sched& S, const Epi& E) {
    const int tid = threadIdx.x, wid = __builtin_amdgcn_readfirstlane(tid >> 6), lane = tid & 63, wr = wid >> 2, wc = wid & 3, fr = lane & 15, fq = lane >> 4;
    const int K = g.K, nt = Epi::HOOKS ? 8 : K / BK;
    unsigned voffA[2], voffB[2];
#pragma unroll
    for (int i = 0; i < 2; ++i) { int R, C; stage_rc(tid * 16 + i * 8192, R, C); const int Rb = Epi::PERM ? ((R & ~31) + perm32(R & 31)) : R;
        voffA[i] = (unsigned)(R * K + C) * 2u; voffB[i] = (unsigned)(Rb * K + C) * 2u; }
    const size_t kstep = (size_t)(BK * 2);
    const size_t hstep = (size_t)HALF * K * 2;
    const size_t tstep = 2 * hstep;
    const unsigned ldsw = (unsigned)wid * 1024u;
    const int aoff = lds_byte(wr * 64 + fr, fq * 8), boff = lds_byte(wc * 32 + fr, fq * 8);
#define PG8_SA(b, h) (((b) * 2 + (h)) * HTB)
#define PG8_SB(b, h) ((4 + (b) * 2 + (h)) * HTB)
#define PG8_STAGE(bufoff, gbase, voff) do { _Pragma("unroll") for (int _i = 0; _i < 2; ++_i) \
        __builtin_amdgcn_global_load_lds((const unsigned*)((const char*)(gbase) + (voff)[_i]), (PG8_LAS unsigned*)(lds + (bufoff) + ldsw + _i * 8192), 16, 0, 0); } while (0)
#define PG8_LDA(dst, b, h) do { _Pragma("unroll") for (int m = 0; m < 4; ++m) _Pragma("unroll") for (int k = 0; k < 2; ++k) dst[m][k] = *(const PG8_LAS bf16x8*)(lds + PG8_SA(b, h) + aoff + m * 2048 + k * 1024); } while (0)
#define PG8_LDB(dst, b, h) do { _Pragma("unroll") for (int n = 0; n < 2; ++n) _Pragma("unroll") for (int k = 0; k < 2; ++k) dst[n][k] = *(const PG8_LAS bf16x8*)(lds + PG8_SB(b, h) + boff + n * 2048 + k * 1024); } while (0)
#define PG8_MMA(ai, bj, At, Bt) do { __builtin_amdgcn_s_setprio(1); _Pragma("unroll") for (int m = 0; m < 4; ++m) _Pragma("unroll") for (int n = 0; n < 2; ++n) _Pragma("unroll") for (int k = 0; k < 2; ++k) \
        acc[ai][bj][m][n] = __builtin_amdgcn_mfma_f32_16x16x32_bf16(Bt[n][k], At[m][k], acc[ai][bj][m][n], 0, 0, 0); __builtin_amdgcn_s_setprio(0); } while (0)
#define PG8_WAIT_V(n) asm volatile("s_waitcnt vmcnt(" #n ")" ::: "memory")
#define PG8_WAIT_L(n) asm volatile("s_waitcnt lgkmcnt(" #n ")" ::: "memory")
#define PG8_BAR __builtin_amdgcn_s_barrier()
#define PG8_SCHED __builtin_amdgcn_sched_barrier(0)
    Unit cur, nxt; int ui = 0;
    if (!S.next(0, cur)) return;
    f32x4 acc[2][2][4][2];
#pragma unroll
    for (int a = 0; a < 2; ++a)
#pragma unroll
        for (int b = 0; b < 2; ++b)
#pragma unroll
            for (int m = 0; m < 4; ++m)
#pragma unroll
                for (int n = 0; n < 2; ++n) acc[a][b][m][n] = (f32x4){0.f, 0.f, 0.f, 0.f};
    bf16x8 At[4][2], B0[2][2], B1[2][2];
    const char* cA = (const char*)g.A + (size_t)cur.pm * tstep + (Epi::HOOKS ? cur.seg * 1024 : 0); const char* cB = (const char*)g.Bt + (size_t)cur.pn * tstep + (Epi::HOOKS ? cur.seg * 1024 : 0);
    S.a_ready(cur);
    PG8_STAGE(PG8_SB(0, 0), cB, voffB); PG8_STAGE(PG8_SA(0, 0), cA, voffA); PG8_STAGE(PG8_SB(0, 1), cB + hstep, voffB); PG8_STAGE(PG8_SA(0, 1), cA + hstep, voffA);
    if (wr == 1) PG8_BAR;
    PG8_WAIT_V(4); PG8_BAR;
    PG8_STAGE(PG8_SB(1, 0), cB + kstep, voffB); PG8_STAGE(PG8_SA(1, 0), cA + kstep, voffA); PG8_STAGE(PG8_SB(1, 1), cB + hstep + kstep, voffB);
    PG8_WAIT_V(6); PG8_BAR;
    for (;;) {
        const bool has_next = S.next(ui + 1, nxt);
        const char* nA = has_next ? (const char*)g.A + (size_t)nxt.pm * tstep + (Epi::HOOKS ? nxt.seg * 1024 : 0) : cA; const char* nB = has_next ? (const char*)g.Bt + (size_t)nxt.pn * tstep + (Epi::HOOKS ? nxt.seg * 1024 : 0) : cB;
        for (int t = 0; t < nt; t += 2) {
            const bool last = (t == nt - 2);
            const char* a1 = cA + (size_t)(t + 1) * kstep;
            const char* a2 = last ? nA : cA + (size_t)(t + 2) * kstep; const char* b2 = last ? nB : cB + (size_t)(t + 2) * kstep;
            const char* a3 = a2 + kstep; const char* b3 = b2 + kstep;
            if (last && has_next) S.a_ready(nxt);
            PG8_LDB(B0, 0, 0); PG8_SCHED; PG8_LDA(At, 0, 0); PG8_STAGE(PG8_SA(1, 1), a1 + hstep, voffA);
            PG8_WAIT_L(8); PG8_BAR; PG8_WAIT_L(0); PG8_MMA(0, 0, At, B0); PG8_BAR; PG8_SCHED;
            PG8_LDB(B1, 0, 1); PG8_STAGE(PG8_SB(0, 0), b2, voffB);
            PG8_BAR; PG8_WAIT_L(0); PG8_MMA(0, 1, At, B1); PG8_BAR;
            PG8_LDA(At, 0, 1); PG8_STAGE(PG8_SA(0, 0), a2, voffA);
            PG8_BAR; PG8_WAIT_L(0); PG8_MMA(1, 0, At, B0); PG8_BAR; PG8_SCHED;
            PG8_STAGE(PG8_SB(0, 1), b2 + hstep, voffB);
            PG8_WAIT_V(6); PG8_BAR; PG8_MMA(1, 1, At, B1); PG8_BAR;
            PG8_LDB(B0, 1, 0); PG8_SCHED; PG8_LDA(At, 1, 0); PG8_STAGE(PG8_SA(0, 1), a2 + hstep, voffA);
            PG8_WAIT_L(8); PG8_BAR; PG8_WAIT_L(0); PG8_MMA(0, 0, At, B0); PG8_BAR; PG8_SCHED;
            PG8_LDB(B1, 1, 1); PG8_STAGE(PG8_SB(1, 0), b3, voffB);
            PG8_BAR; PG8_WAIT_L(0); PG8_MMA(0, 1, At, B1); PG8_BAR;
            PG8_LDA(At, 1, 1); PG8_STAGE(PG8_SA(1, 0), a3, voffA);
            PG8_BAR; PG8_WAIT_L(0); PG8_MMA(1, 0, At, B0); PG8_BAR; PG8_SCHED;
            PG8_STAGE(PG8_SB(1, 1), b3 + hstep, voffB);
            PG8_WAIT_V(6); PG8_BAR; PG8_MMA(1, 1, At, B1); PG8_BAR;
        }
        if constexpr (!Epi::AFTER_DRAIN) { E(acc, cur, wr, wc, fr, fq); S.done(cur); }
        if (!has_next) break;
        if (!Epi::HOOKS)
#pragma unroll
        for (int a = 0; a < 2; ++a)
#pragma unroll
            for (int b = 0; b < 2; ++b)
#pragma unroll
                for (int m = 0; m < 4; ++m)
#pragma unroll
                    for (int n = 0; n < 2; ++n) acc[a][b][m][n] = (f32x4){0.f, 0.f, 0.f, 0.f};
        cur = nxt; cA = nA; cB = nB; ++ui;
    }
    PG8_WAIT_V(0);
    if (wr == 0) PG8_BAR;
    PG8_BAR;
    if constexpr (Epi::AFTER_DRAIN) { E.fused(acc, cur, wr, wc, fr, fq, lds, wid, lane); S.done(cur); }
#undef PG8_SA
#undef PG8_SB
#undef PG8_STAGE
#undef PG8_LDA
#undef PG8_LDB
#undef PG8_MMA
#undef PG8_WAIT_V
#undef PG8_WAIT_L
#undef PG8_BAR
#undef PG8_SCHED
}
}

#ifndef REP_PHASE
#define REP_PHASE -1
#endif

__device__ __forceinline__ void tr_item(const float* __restrict__ W, int ldw, int k0, int c0, bf16_t* WT, int ldt, int d0, int kd0, const float* __restrict__ kscale, LAS float* scr, int lane) {
#pragma unroll 8
    for (int i = 0; i < 32; ++i) { const int kk = 2 * i + (lane >> 5); float v = W[(size_t)(k0 + kk) * ldw + c0 + (lane & 31)]; if (kscale) v *= kscale[k0 + kk]; scr[kk * 33 + (lane & 31)] = v; }
    LDS_WAIT();
    const int c = lane & 7;
#pragma unroll
    for (int j = 0; j < 4; ++j) { const int n = (lane >> 3) + 8 * j; const LAS float* s = scr + (8 * c) * 33 + n;
        u32x4 o; o.x = cvt_pk_bf16(s[0], s[33]); o.y = cvt_pk_bf16(s[66], s[99]); o.z = cvt_pk_bf16(s[132], s[165]); o.w = cvt_pk_bf16(s[198], s[231]);
        *(u32x4*)(WT + (size_t)(d0 + n) * ldt + kd0 + 8 * c) = o; }
    LDS_WAIT();
}

__device__ __forceinline__ void phase0(const Params& p, LAS unsigned char* lds) {
    const int tid = threadIdx.x, lane = tid & 63, wave = tid >> 6, G = gridDim.x;
    const int gw = blockIdx.x * 8 + wave, NGW = G * 8;
    unsigned char* ws = p.ws;
    bf16_t* WIN = (bf16_t*)(ws + WS_WIN); bf16_t* WCAT = (bf16_t*)(ws + WS_WCAT); bf16_t* WOUT = (bf16_t*)(ws + WS_WOUT); bf16_t* PMIX = (bf16_t*)(ws + WS_PMIX);
    bf16_t* HB = (bf16_t*)(p.out + O_YP); float* DT = (float*)(ws + WS_DT);
    { float* z = (float*)(ws + WS_SSQ); for (int i = blockIdx.x * 512 + tid; i < 3 * MTOK; i += G * 512) z[i] = 0.f;
      if (blockIdx.x == 0 && tid == 0) *(unsigned*)(ws + WS_CTL) = 0u; }
    LAS float* wdt = (LAS float*)lds;
    for (int e = tid; e < 4096; e += 512) { const int k = e >> 2, j4 = e & 3; const f32x4 v = *(const f32x4*)(p.w_in + (size_t)k * DIN + 2560 + 4 * j4);
        wdt[(4 * j4 + 0) * 1024 + k] = v.x; wdt[(4 * j4 + 1) * 1024 + k] = v.y; wdt[(4 * j4 + 2) * 1024 + k] = v.z; wdt[(4 * j4 + 3) * 1024 + k] = v.w; }
    LAS float* scr = (LAS float*)(lds + 65536 + wave * 8448);
    constexpr int I_IN = 16 * 176, I_A = 16 * 32, I_B = 8 * 32, I_O = 16 * 32, I_P = 4 * 8, NIT = I_IN + I_A + I_B + I_O + I_P;
    for (int it = gw; it < NIT; it += NGW) {
        int r = it;
        if (r < I_IN) { const int kb = r / 176, nb = r % 176, d0 = 32 * nb, c0 = d0 + (d0 >= 2560 ? 16 : 0); tr_item(p.w_in, DIN, 64 * kb, c0, WIN, 1024, d0, 64 * kb, nullptr, scr, lane); continue; } r -= I_IN;
        if (r < I_A) { const int kb = r >> 5, nb = r & 31; tr_item(p.w_a, 1024, 64 * kb, 32 * nb, WCAT, KCAT, 32 * nb, 64 * kb, p.ssm_norm, scr, lane); continue; } r -= I_A;
        if (r < I_B) { const int kb = r >> 5, nb = r & 31; tr_item(p.w_b, 1024, 64 * kb, 32 * nb, WCAT, KCAT, 32 * nb, 1024 + 64 * kb, nullptr, scr, lane); continue; } r -= I_B;
        if (r < I_O) { const int kb = r >> 5, nb = r & 31; tr_item(p.w_out, 1024, 64 * kb, 32 * nb, WOUT, 1024, 32 * nb, 64 * kb, nullptr, scr, lane); continue; } r -= I_O;
        { const int k = r >> 3, kb = (r >> 2) & 1, nb = r & 3; tr_item(p.pool_mix + (size_t)k * 16384, 128, 64 * kb, 32 * nb, PMIX + (size_t)k * 16384, 128, 32 * nb, 64 * kb, nullptr, scr, lane); }
    }
    __syncthreads();
    const int jmine = (lane & 1) * 8 + ((lane >> 1) & 1) * 4 + ((lane >> 2) & 1) * 2 + ((lane >> 3) & 1);
    const float dtb = p.dt_bias[jmine];
    f32x4 g4[4];
#pragma unroll
    for (int j = 0; j < 4; ++j) g4[j] = ((const f32x4*)p.norm_pre)[lane + 64 * j];
    f32x4 nx[4];
    { const int m = gw; if (m < MTOK) { const float* xrow = m < NTOK_P ? p.x_p + (size_t)m * DM : p.x_s + (size_t)(m - NTOK_P) * DM;
#pragma unroll
        for (int j = 0; j < 4; ++j) nx[j] = ((const f32x4*)xrow)[lane + 64 * j]; } }
    for (int m = gw; m < MTOK; m += NGW) {
        f32x4 v[4]; float ss = 0.f;
#pragma unroll
        for (int j = 0; j < 4; ++j) { v[j] = nx[j]; ss += (v[j].x * v[j].x + v[j].y * v[j].y) + (v[j].z * v[j].z + v[j].w * v[j].w); }
        { const int m2 = m + NGW; if (m2 < MTOK) { const float* xrow = m2 < NTOK_P ? p.x_p + (size_t)m2 * DM : p.x_s + (size_t)(m2 - NTOK_P) * DM;
#pragma unroll
            for (int j = 0; j < 4; ++j) nx[j] = ((const f32x4*)xrow)[lane + 64 * j]; } }
        const float rstd = rsqrtf(wave_sum(ss) * (1.f / DM) + EPS);
        unsigned long long* o8 = (unsigned long long*)(HB + (size_t)m * DM);
#pragma unroll
        for (int j = 0; j < 4; ++j) { v[j] = v[j] * rstd * g4[j];
            o8[lane + 64 * j] = (unsigned long long)cvt_pk_bf16(v[j].x, v[j].y) | ((unsigned long long)cvt_pk_bf16(v[j].z, v[j].w) << 32); }
        float d[16];
#pragma unroll
        for (int jj = 0; jj < 16; ++jj) { float s = 0.f;
#pragma unroll
            for (int j = 0; j < 4; ++j) { const f32x4 w4 = *(const LAS f32x4*)(wdt + jj * 1024 + 4 * lane + 256 * j); s += (v[j].x * w4.x + v[j].y * w4.y) + (v[j].z * w4.z + v[j].w * w4.w); }
            d[jj] = s; }
#pragma unroll
        for (int i = 0; i < 8; ++i) { const bool hi = lane & 1; const float send = hi ? d[i] : d[i + 8], keep = hi ? d[i + 8] : d[i]; d[i] = keep + __shfl_xor(send, 1); }
#pragma unroll
        for (int i = 0; i < 4; ++i) { const bool hi = lane & 2; const float send = hi ? d[i] : d[i + 4], keep = hi ? d[i + 4] : d[i]; d[i] = keep + __shfl_xor(send, 2); }
#pragma unroll
        for (int i = 0; i < 2; ++i) { const bool hi = lane & 4; const float send = hi ? d[i] : d[i + 2], keep = hi ? d[i + 2] : d[i]; d[i] = keep + __shfl_xor(send, 4); }
        { const bool hi = lane & 8; const float send = hi ? d[0] : d[1], keep = hi ? d[1] : d[0]; d[0] = keep + __shfl_xor(send, 8); }
        float mine = d[0]; mine += __shfl_xor(mine, 16); mine += __shfl_xor(mine, 32);
        if (lane < 16) { const float a = mine + dtb; DT[(size_t)m * 16 + jmine] = a > 20.f ? a : log1pf(__expf(a)); }
    }
}

__device__ __forceinline__ void phase_conv(const Params& p) {
    const bf16_t* PROJ = (const bf16_t*)(p.ws + WS_PROJ); bf16_t* ACT = (bf16_t*)(p.ws + WS_X);
    const int T = gridDim.x * 512, gt = blockIdx.x * 512 + threadIdx.x;
    constexpr int NCP = CONVD / 2, NU = (MTOK / 8) * NCP;
    for (int u = gt; u < NU; u += T) {
        const int cp = u % NCP, ru = u / NCP, row0 = ru * 8, ch = 2 * cp;
        float w[4][2], in0[11], in1[11];
#pragma unroll
        for (int k = 0; k < 4; ++k) { const f32x2 t = *(const f32x2*)(p.conv_w + k * CONVD + ch); w[k][0] = t.x; w[k][1] = t.y; }
        const f32x2 bias = *(const f32x2*)(p.conv_b + ch);
        const bool prompt = row0 < NTOK_P; const int tb = row0 & (SEQ - 1), sb = (row0 - NTOK_P) >> 3;
        const bf16_t* col = PROJ + (size_t)row0 * NPROJ + C_XBC + ch;
#pragma unroll
        for (int i = 0; i < 11; ++i) {
            if (i >= 3 || (prompt && tb > 0)) { const unsigned v = *(const unsigned*)(col + (ptrdiff_t)(i - 3) * NPROJ); in0[i] = bf_lo(v); in1[i] = bf_hi(v); }
            else if (prompt) { in0[i] = 0.f; in1[i] = 0.f; }
            else { const f32x2 t = *(const f32x2*)(p.st_conv + ((size_t)sb * 3 + i) * CONVD + ch); in0[i] = t.x; in1[i] = t.y; }
        }
#pragma unroll
        for (int i = 0; i < 8; ++i) { float v0 = bias.x, v1 = bias.y;
#pragma unroll
            for (int k = 0; k < 4; ++k) { v0 += w[k][0] * in0[i + k]; v1 += w[k][1] * in1[i + k]; }
            *(unsigned*)(ACT + (size_t)(row0 + i) * KCAT + ch) = cvt_pk_bf16(silu_f(v0), silu_f(v1)); }
    }
}

constexpr int PIT = 272;
constexpr int OFF_C = 0, OFF_B = 34816, OFF_BT = 69632, OFF_XT = 104448, OFF_H = 121856, OFF_SM = 139264, OFF_MISC = OFF_SM + 2048;
static_assert(OFF_MISC + 64 <= LDS_BYTES, "lds");

__device__ __forceinline__ void ssd_prompt_item(const Params& p, LAS unsigned char* lds, int item, float ssq_scale) {
    int tid_ = threadIdx.x; asm volatile("" : "+v"(tid_));
    const int tid = tid_, wid = __builtin_amdgcn_readfirstlane(tid >> 6), lane = tid & 63, r = lane & 15, q = lane >> 4;
    const int b = item >> 4, head = item & 15, g = head >> 3;
    const bf16_t* PROJ = (const bf16_t*)(p.ws + WS_PROJ); const bf16_t* ACT = (const bf16_t*)(p.ws + WS_X); const float* DT = (const float*)(p.ws + WS_DT); float* SSQ = (float*)(p.ws + WS_SSQ);
    bf16_t* YCAT = (bf16_t*)(p.out + O_YP);
    const float a_h = -__expf(p.a_log[head]), Dh = p.d_skip[head];
    LAS float* dts = (LAS float*)(lds + OFF_SM); LAS float* acs = dts + 128; LAS float* wsd = dts + 256; LAS float* misc = dts + 384;
    const int xp = tid & 31, xseg = tid >> 5, bp = tid & 63, bseg = tid >> 6, cg8 = tid & 15, ct = tid >> 4;
    const size_t row00 = (size_t)b * SEQ;
    const bf16_t* xcol = ACT + (row00 + xseg * 8) * KCAT + head * 64 + 2 * xp;
    const bf16_t* bcol = ACT + (row00 + bseg * 16) * KCAT + 1024 + g * 128 + 2 * bp;
    const bf16_t* ccol = ACT + (row00 + ct) * KCAT + 1280 + g * 128 + 8 * cg8;
    f32x4 hacc[4];
#pragma unroll
    for (int i = 0; i < 4; ++i) hacc[i] = (f32x4){0.f, 0.f, 0.f, 0.f};
    for (int i = tid; i < 17408 / 4; i += 512) ((LAS unsigned*)(lds + OFF_H))[i] = 0u;
    float dtn0 = 0.f, dtn1 = 0.f;
    if (wid == 0) { dtn0 = DT[(row00 + 2 * lane) * 16 + head]; dtn1 = DT[(row00 + 2 * lane + 1) * 16 + head]; }
    unsigned px[8], pbv[16]; u32x4 pc[4];
#define SSD_ISSUE(c) do { const size_t ro_ = (size_t)(c) * 128 * KCAT; \
        _Pragma("unroll") for (int i = 0; i < 8; ++i) px[i] = *(const unsigned*)(xcol + ro_ + (size_t)i * KCAT); \
        _Pragma("unroll") for (int i = 0; i < 16; ++i) pbv[i] = *(const unsigned*)(bcol + ro_ + (size_t)i * KCAT); \
        _Pragma("unroll") for (int i = 0; i < 4; ++i) pc[i] = *(const u32x4*)(ccol + ro_ + (size_t)(32 * i) * KCAT); } while (0)
    SSD_ISSUE(0);
    const int lt = wid, l0 = 16 * wid;
    for (int c = 0; c < SEQ / 128; ++c) {
        const size_t rowb = row00 + (size_t)c * 128;
        if (wid == 0) {
            const float d0 = dtn0, d1 = dtn1, v0 = d0 * a_h, v1 = d1 * a_h;
            if (c + 1 < SEQ / 128) { dtn0 = DT[(rowb + 128 + 2 * lane) * 16 + head]; dtn1 = DT[(rowb + 128 + 2 * lane + 1) * 16 + head]; }
            float x = v0 + v1;
#pragma unroll
            for (int o = 1; o < 64; o <<= 1) { const float t = __shfl_up(x, o); if (lane >= o) x += t; }
            const float tot = __shfl(x, 63), a1 = x, a0 = x - v1;
            dts[2 * lane] = d0; dts[2 * lane + 1] = d1; acs[2 * lane] = a0; acs[2 * lane + 1] = a1;
            wsd[2 * lane] = d0 * __expf(tot - a0); wsd[2 * lane + 1] = d1 * __expf(tot - a1);
            if (lane == 0) misc[0] = __expf(tot);
        }
        __syncthreads();
        {   u32x4 w0, w1;
            w0.x = (px[0] & 0xffffu) | (px[1] << 16); w0.y = (px[2] & 0xffffu) | (px[3] << 16); w0.z = (px[4] & 0xffffu) | (px[5] << 16); w0.w = (px[6] & 0xffffu) | (px[7] << 16);
            w1.x = (px[0] >> 16) | (px[1] & 0xffff0000u); w1.y = (px[2] >> 16) | (px[3] & 0xffff0000u); w1.z = (px[4] >> 16) | (px[5] & 0xffff0000u); w1.w = (px[6] >> 16) | (px[7] & 0xffff0000u);
            *(LAS u32x4*)(lds + OFF_XT + (2 * xp) * PIT + xseg * 16) = w0; *(LAS u32x4*)(lds + OFF_XT + (2 * xp + 1) * PIT + xseg * 16) = w1; }
        {
#pragma unroll
            for (int i = 0; i < 16; ++i) *(LAS unsigned*)(lds + OFF_B + (bseg * 16 + i) * PIT + bp * 4) = pbv[i];
            float wv[16];
#pragma unroll
            for (int i = 0; i < 4; ++i) { const f32x4 t = *(const LAS f32x4*)(wsd + bseg * 16 + 4 * i); wv[4 * i] = t.x; wv[4 * i + 1] = t.y; wv[4 * i + 2] = t.z; wv[4 * i + 3] = t.w; }
#pragma unroll
            for (int hh = 0; hh < 2; ++hh) { u32x4 wa, wb;
#pragma unroll
                for (int j = 0; j < 4; ++j) { const int i0 = 8 * hh + 2 * j, i1 = i0 + 1;
                    wa[j] = cvt_pk_bf16(bf_lo(pbv[i0]) * wv[i0], bf_lo(pbv[i1]) * wv[i1]); wb[j] = cvt_pk_bf16(bf_hi(pbv[i0]) * wv[i0], bf_hi(pbv[i1]) * wv[i1]); }
                *(LAS u32x4*)(lds + OFF_BT + (2 * bp) * PIT + bseg * 32 + hh * 16) = wa; *(LAS u32x4*)(lds + OFF_BT + (2 * bp + 1) * PIT + bseg * 32 + hh * 16) = wb; }
        }
#pragma unroll
        for (int i = 0; i < 4; ++i) *(LAS u32x4*)(lds + OFF_C + (ct + 32 * i) * PIT + cg8 * 16) = pc[i];
        __syncthreads();
        if (c + 1 < SEQ / 128) SSD_ISSUE(c + 1);
        bf16x8 cf[4];
#pragma unroll
        for (int kk = 0; kk < 4; ++kk) cf[kk] = *(const LAS bf16x8*)(lds + OFF_C + (l0 + r) * PIT + kk * 64 + q * 16);
        f32x4 gacc[8];
#pragma unroll
        for (int st = 0; st < 8; ++st) { gacc[st] = (f32x4){0.f, 0.f, 0.f, 0.f};
            if (st <= lt) {
#pragma unroll
                for (int kk = 0; kk < 4; ++kk) { const bf16x8 bf = *(const LAS bf16x8*)(lds + OFF_B + (16 * st + r) * PIT + kk * 64 + q * 16); gacc[st] = MFMA16(bf, cf[kk], gacc[st]); } } }
        __syncthreads();
        const float acl = acs[l0 + r];
#pragma unroll
        for (int st = 0; st < 8; ++st) {
            if (st <= (lt | 1)) { const int s0 = 16 * st + 4 * q; const f32x4 as = *(const LAS f32x4*)(acs + s0), ds = *(const LAS f32x4*)(dts + s0); float mv[4];
#pragma unroll
                for (int j = 0; j < 4; ++j) { const bool ok = (st <= lt) && (l0 + r >= s0 + j); mv[j] = ok ? gacc[st][j] * __expf(acl - as[j]) * ds[j] : 0.f; }
                u32x2 w; w.x = cvt_pk_bf16(mv[0], mv[1]); w.y = cvt_pk_bf16(mv[2], mv[3]);
                *(LAS u32x2*)(lds + OFF_B + (l0 + r) * PIT + s0 * 2) = w; } }
        __syncthreads();
        f32x4 yd[4], yo[4];
#pragma unroll
        for (int i = 0; i < 4; ++i) { yd[i] = (f32x4){0.f, 0.f, 0.f, 0.f}; yo[i] = (f32x4){0.f, 0.f, 0.f, 0.f}; }
        const int kmax = lt >> 1;
#pragma unroll
        for (int kk = 0; kk < 4; ++kk) {
            if (kk <= kmax) { const bf16x8 mf = *(const LAS bf16x8*)(lds + OFF_B + (l0 + r) * PIT + kk * 64 + q * 16);
#pragma unroll
                for (int pt = 0; pt < 4; ++pt) { const bf16x8 xf = *(const LAS bf16x8*)(lds + OFF_XT + (16 * pt + r) * PIT + kk * 64 + q * 16); yd[pt] = MFMA16(xf, mf, yd[pt]); } }
#pragma unroll
            for (int pt = 0; pt < 4; ++pt) { const bf16x8 hf = *(const LAS bf16x8*)(lds + OFF_H + (16 * pt + r) * PIT + kk * 64 + q * 16); yo[pt] = MFMA16(hf, cf[kk], yo[pt]); }
        }
        { const float eend = misc[0];
#pragma unroll
          for (int pt = 0; pt < 4; ++pt) hacc[pt] *= eend;
#pragma unroll
          for (int kk = 0; kk < 4; ++kk) { const bf16x8 btf = *(const LAS bf16x8*)(lds + OFF_BT + (16 * wid + r) * PIT + kk * 64 + q * 16);
#pragma unroll
              for (int pt = 0; pt < 4; ++pt) { const bf16x8 xf = *(const LAS bf16x8*)(lds + OFF_XT + (16 * pt + r) * PIT + kk * 64 + q * 16); hacc[pt] = MFMA16(btf, xf, hacc[pt]); } } }
        { const float el = __expf(acl); const size_t row = rowb + l0 + r; float ss = 0.f;
#pragma unroll
          for (int pt = 0; pt < 4; ++pt) { const int p0 = 16 * pt + 4 * q; const u32x2 z2 = *(const u32x2*)(PROJ + row * NPROJ + C_Z + head * 64 + p0); float y[4];
#pragma unroll
              for (int j = 0; j < 4; ++j) { const float xv = bf2f(*(const LAS bf16_t*)(lds + OFF_XT + (p0 + j) * PIT + (l0 + r) * 2));
                  const unsigned zw = (j < 2) ? z2.x : z2.y; const float zv = (j & 1) ? bf_hi(zw) : bf_lo(zw);
                  y[j] = (yd[pt][j] + el * yo[pt][j] + Dh * xv) * silu_f(zv); ss += y[j] * y[j]; }
              u32x2 w; w.x = cvt_pk_bf16(y[0], y[1]); w.y = cvt_pk_bf16(y[2], y[3]);
              *(u32x2*)(YCAT + row * KCAT + head * 64 + p0) = w; }
          ss += __shfl_xor(ss, 16); ss += __shfl_xor(ss, 32);
          if (q == 0) atomicAdd(SSQ + row * 2 + g, ss * ssq_scale); }
        __syncthreads();
#pragma unroll
        for (int pt = 0; pt < 4; ++pt) { u32x2 w; w.x = cvt_pk_bf16(hacc[pt][0], hacc[pt][1]); w.y = cvt_pk_bf16(hacc[pt][2], hacc[pt][3]);
            *(LAS u32x2*)(lds + OFF_H + (16 * pt + r) * PIT + (16 * wid + 4 * q) * 2) = w; }
    }
#undef SSD_ISSUE
    float* so = p.out + O_SSMP + ((size_t)(b * NH + head) * HD) * DS;
#pragma unroll
    for (int pt = 0; pt < 4; ++pt) *(f32x4*)(so + (size_t)(16 * pt + r) * DS + 16 * wid + 4 * q) = hacc[pt];
}

template <int W> __device__ __forceinline__ void pool_build(const Params& p, LAS unsigned char* lds, int row0, int k) {
    int tid_ = threadIdx.x; asm volatile("" : "+v"(tid_));
    const int tid = tid_, cp = tid & 63, ts0 = (tid >> 6) * 16;
    const bf16_t* PROJ = (const bf16_t*)(p.ws + WS_PROJ);
    const bf16_t* ucol = PROJ + C_U + k * 128 + 2 * cp;
    constexpr float invW = 1.f / (float)W;
    if (row0 < NTOK_P) {
        const int tb = (row0 & (SEQ - 1)) + ts0; const size_t rw = (size_t)row0 + ts0;
        unsigned raw[W - 1 + 16];
#pragma unroll
        for (int i = 0; i < W - 1 + 16; ++i) raw[i] = (tb + i - (W - 1)) >= 0 ? *(const unsigned*)(ucol + (rw + i - (W - 1)) * NPROJ) : 0u;
        float r0 = 0.f, r1 = 0.f;
#pragma unroll
        for (int i = 0; i < W - 1; ++i) { r0 += bf_lo(raw[i]); r1 += bf_hi(raw[i]); }
#pragma unroll
        for (int i = 0; i < 16; ++i) { const float c0 = bf_lo(raw[i + W - 1]), c1 = bf_hi(raw[i + W - 1]); r0 += c0; r1 += c1;
            const int cnt = min(tb + i + 1, W); const float ic = cnt == W ? invW : __builtin_amdgcn_rcpf((float)cnt);
            *(LAS unsigned*)(lds + (ts0 + i) * PIT + cp * 4) = cvt_pk_bf16(r0 * ic - c0, r1 * ic - c1);
            r0 -= bf_lo(raw[i]); r1 -= bf_hi(raw[i]); }
    } else {
#pragma unroll
        for (int hb = 0; hb < 2; ++hb) { const int row = row0 + ts0 + 8 * hb, bb = (row - NTOK_P) >> 3;
            float e0[W - 1 + 8], e1[W - 1 + 8];
#pragma unroll
            for (int i = 0; i < W - 1; ++i) { const f32x2 sv = *(const f32x2*)(p.st_pool + ((size_t)bb * 15 + 15 - (W - 1) + i) * DPOOL + k * 128 + 2 * cp); e0[i] = sv.x; e1[i] = sv.y; }
#pragma unroll
            for (int i = 0; i < 8; ++i) { const unsigned u = *(const unsigned*)(ucol + (size_t)(row + i) * NPROJ); e0[W - 1 + i] = bf_lo(u); e1[W - 1 + i] = bf_hi(u); }
            float r0 = 0.f, r1 = 0.f;
#pragma unroll
            for (int i = 0; i < W - 1; ++i) { r0 += e0[i]; r1 += e1[i]; }
#pragma unroll
            for (int i = 0; i < 8; ++i) { const float c0 = e0[W - 1 + i], c1 = e1[W - 1 + i]; r0 += c0; r1 += c1;
                *(LAS unsigned*)(lds + (ts0 + 8 * hb + i) * PIT + cp * 4) = cvt_pk_bf16(r0 * invW - c0, r1 * invW - c1);
                r0 -= e0[i]; r1 -= e1[i]; } }
    }
}
__device__ __forceinline__ void pool_item(const Params& p, LAS unsigned char* lds, int j) {
    int tid_ = threadIdx.x; asm volatile("" : "+v"(tid_));
    const int tid = tid_, wid = __builtin_amdgcn_readfirstlane(tid >> 6), lane = tid & 63, r = lane & 15, q = lane >> 4;
    const bf16_t* PROJ = (const bf16_t*)(p.ws + WS_PROJ); const bf16_t* PMIX = (const bf16_t*)(p.ws + WS_PMIX); bf16_t* YCAT = (bf16_t*)(p.out + O_YP);
    const int row0 = 128 * j;
    for (int k = 0; k < 4; ++k) {
        if (k == 0) pool_build<2>(p, lds, row0, 0); else if (k == 1) pool_build<4>(p, lds, row0, 1); else if (k == 2) pool_build<8>(p, lds, row0, 2); else pool_build<16>(p, lds, row0, 3);
        __syncthreads();
        bf16x8 mf[4];
#pragma unroll
        for (int kk = 0; kk < 4; ++kk) mf[kk] = *(const bf16x8*)(PMIX + ((size_t)k * 128 + 16 * wid + r) * 128 + kk * 32 + q * 8);
        const int d0 = k * 128 + 16 * wid + 4 * q; const f32x4 sc = *(const f32x4*)(p.pool_scale + d0);
        u32x2 g2[8];
#pragma unroll
        for (int tt = 0; tt < 8; ++tt) g2[tt] = *(const u32x2*)(PROJ + ((size_t)row0 + 16 * tt + r) * NPROJ + C_G + d0);
#pragma unroll
        for (int tt = 0; tt < 8; ++tt) { f32x4 acc = (f32x4){0.f, 0.f, 0.f, 0.f};
#pragma unroll
            for (int kk = 0; kk < 4; ++kk) { const bf16x8 af = *(const LAS bf16x8*)(lds + (16 * tt + r) * PIT + kk * 64 + q * 16); acc = MFMA16(mf[kk], af, acc); }
            const size_t row = (size_t)row0 + 16 * tt + r;
            const float y0 = acc[0] * sc.x * silu_f(bf_lo(g2[tt].x)), y1 = acc[1] * sc.y * silu_f(bf_hi(g2[tt].x)), y2 = acc[2] * sc.z * silu_f(bf_lo(g2[tt].y)), y3 = acc[3] * sc.w * silu_f(bf_hi(g2[tt].y));
            u32x2 w; w.x = cvt_pk_bf16(y0, y1); w.y = cvt_pk_bf16(y2, y3);
            *(u32x2*)(YCAT + row * KCAT + 1024 + d0) = w; }
        __syncthreads();
    }
}

constexpr int SMP_LDS = 10752;
__device__ __forceinline__ void ssd_sample_wave(const Params& p, LAS unsigned char* lds, int it, float ssq_scale) {
    int tid_ = threadIdx.x; asm volatile("" : "+v"(tid_));
    const int tid = tid_, wid = __builtin_amdgcn_readfirstlane(tid >> 6), lane = tid & 63, r = lane & 15, q = lane >> 4;
    const int b = it >> 4, head = it & 15, g = head >> 3;
    const bf16_t* PROJ = (const bf16_t*)(p.ws + WS_PROJ); const bf16_t* ACT = (const bf16_t*)(p.ws + WS_X); const float* DT = (const float*)(p.ws + WS_DT); float* SSQ = (float*)(p.ws + WS_SSQ); bf16_t* YCAT = (bf16_t*)(p.out + O_YP);
    LAS float* xs = (LAS float*)(lds + wid * SMP_LDS); LAS float* Bs = xs + 512; LAS float* Cs = Bs + 1024; LAS float* Ms = Cs + 1024;
    const size_t row0 = (size_t)NTOK_P + (size_t)b * LS;
    const float* hin = p.st_ssm + ((size_t)(b * NH + head) * HD) * DS; float* hout = p.out + O_SSMS + ((size_t)(b * NH + head) * HD) * DS;
    f32x4 hn[4];
#pragma unroll
    for (int pt = 0; pt < 4; ++pt) hn[pt] = *(const f32x4*)(hin + (size_t)(16 * pt + r) * DS + 4 * q);
    {   const int t = lane >> 3, gi = lane & 7; const bf16_t* arow = ACT + (row0 + t) * KCAT;
        const u32x4 xv = *(const u32x4*)(arow + head * 64 + 8 * gi), b0 = *(const u32x4*)(arow + 1024 + g * 128 + 8 * gi), b1 = *(const u32x4*)(arow + 1024 + g * 128 + 64 + 8 * gi),
                    c0 = *(const u32x4*)(arow + 1280 + g * 128 + 8 * gi), c1 = *(const u32x4*)(arow + 1280 + g * 128 + 64 + 8 * gi);
#define SMP_PUT(dst, v) do { *(LAS f32x4*)(dst) = (f32x4){bf_lo((v).x), bf_hi((v).x), bf_lo((v).y), bf_hi((v).y)}; *(LAS f32x4*)((dst) + 4) = (f32x4){bf_lo((v).z), bf_hi((v).z), bf_lo((v).w), bf_hi((v).w)}; } while (0)
        SMP_PUT(xs + t * 64 + 8 * gi, xv); SMP_PUT(Bs + t * 128 + 8 * gi, b0); SMP_PUT(Bs + t * 128 + 64 + 8 * gi, b1); SMP_PUT(Cs + t * 128 + 8 * gi, c0); SMP_PUT(Cs + t * 128 + 64 + 8 * gi, c1);
#undef SMP_PUT
    }
    const float a_h = -__expf(p.a_log[head]), Dh = p.d_skip[head];
    const float dtl = DT[(row0 + (lane & 7)) * 16 + head];
    float acl = dtl * a_h;
#pragma unroll
    for (int o = 1; o < 8; o <<= 1) { const float t = __shfl_up(acl, o, 8); if ((lane & 7) >= o) acl += t; }
    const float ac7 = __shfl(acl, 7, 8);
    LDS_WAIT();
    {
        const int l = lane >> 3, s = lane & 7; float acc = 0.f;
#pragma unroll 8
        for (int n = 0; n < 128; n += 4) { const f32x4 cv = *(const LAS f32x4*)(Cs + l * 128 + n), bv = *(const LAS f32x4*)(Bs + s * 128 + n); acc += (cv.x * bv.x + cv.y * bv.y) + (cv.z * bv.z + cv.w * bv.w); }
        const float al = __shfl(acl, l);
        Ms[lane] = s <= l ? acc * __expf(al - acl) * dtl : 0.f;
    }
    float xw[4][8];
    const float wl = dtl * __expf(ac7 - acl);
#pragma unroll
    for (int s = 0; s < 8; ++s) { const float ws_ = __shfl(wl, s);
#pragma unroll
        for (int pt = 0; pt < 4; ++pt) xw[pt][s] = xs[s * 64 + 16 * pt + r] * ws_; }
    const float eend = __expf(ac7);
    float yo[4][8];
#pragma unroll
    for (int pt = 0; pt < 4; ++pt)
#pragma unroll
        for (int l = 0; l < 8; ++l) yo[pt][l] = 0.f;
#pragma unroll 1
    for (int nt = 0; nt < 8; ++nt) {
        f32x4 h[4];
#pragma unroll
        for (int pt = 0; pt < 4; ++pt) h[pt] = hn[pt];
        if (nt + 1 < 8) {
#pragma unroll
            for (int pt = 0; pt < 4; ++pt) hn[pt] = *(const f32x4*)(hin + (size_t)(16 * pt + r) * DS + 16 * (nt + 1) + 4 * q); }
        const int n4 = 16 * nt + 4 * q;
#pragma unroll
        for (int l = 0; l < 8; ++l) { const f32x4 cv = *(const LAS f32x4*)(Cs + l * 128 + n4);
#pragma unroll
            for (int pt = 0; pt < 4; ++pt) yo[pt][l] += (cv.x * h[pt].x + cv.y * h[pt].y) + (cv.z * h[pt].z + cv.w * h[pt].w); }
#pragma unroll
        for (int pt = 0; pt < 4; ++pt) h[pt] *= eend;
#pragma unroll
        for (int s = 0; s < 8; ++s) { const f32x4 bv = *(const LAS f32x4*)(Bs + s * 128 + n4);
#pragma unroll
            for (int pt = 0; pt < 4; ++pt) h[pt] += bv * xw[pt][s]; }
#pragma unroll
        for (int pt = 0; pt < 4; ++pt) *(f32x4*)(hout + (size_t)(16 * pt + r) * DS + n4) = h[pt];
    }
#pragma unroll
    for (int pt = 0; pt < 4; ++pt)
#pragma unroll
        for (int l = 0; l < 8; ++l) { float v = yo[pt][l]; v += __shfl_xor(v, 16); v += __shfl_xor(v, 32); yo[pt][l] = v; }
    LDS_WAIT();
#pragma unroll
    for (int e = 0; e < 2; ++e) { const int l = 2 * q + e; const float al = __shfl(acl, l), el = __expf(al); float ss = 0.f;
#pragma unroll
        for (int pt = 0; pt < 4; ++pt) { const int pp = 16 * pt + r;
            const float yoff = e == 0 ? (q == 0 ? yo[pt][0] : q == 1 ? yo[pt][2] : q == 2 ? yo[pt][4] : yo[pt][6]) : (q == 0 ? yo[pt][1] : q == 1 ? yo[pt][3] : q == 2 ? yo[pt][5] : yo[pt][7]);
            float y = el * yoff;
            for (int s = 0; s <= l; ++s) y += Ms[l * 8 + s] * xs[s * 64 + pp];
            y += Dh * xs[l * 64 + pp];
            y *= silu_f(bf2f(PROJ[(row0 + l) * NPROJ + C_Z + head * 64 + pp]));
            ss += y * y;
            YCAT[(row0 + l) * KCAT + head * 64 + pp] = (bf16_t)(cvt_pk_bf16(y, 0.f) & 0xffffu); }
        ss += __shfl_xor(ss, 1); ss += __shfl_xor(ss, 2); ss += __shfl_xor(ss, 4); ss += __shfl_xor(ss, 8);
        if (r == 0) atomicAdd(SSQ + (row0 + l) * 2 + g, ss * ssq_scale); }
    LDS_WAIT();
}

constexpr int E_CP = NB_P * 3 * CONVD, E_PP = NB_P * 15 * DPOOL, E_CS = NB_S * 3 * CONVD, E_PS = NB_S * 15 * DPOOL, E_ALL = E_CP + E_PP + E_CS + E_PS, N_COPY = 64;
__device__ __forceinline__ void copy_item(const Params& p, int it) {
    const bf16_t* PROJ = (const bf16_t*)(p.ws + WS_PROJ);
    constexpr int PER = E_ALL / N_COPY; static_assert(E_ALL % N_COPY == 0, "copy split");
    for (int e = it * PER + threadIdx.x; e < (it + 1) * PER; e += 512) {
        int r = e;
        if (r < E_CP) { const int b = r / (3 * CONVD), rem = r % (3 * CONVD), j = rem / CONVD, ch = rem % CONVD; p.out[O_CONVP + r] = bf2f(PROJ[((size_t)b * SEQ + SEQ - 3 + j) * NPROJ + C_XBC + ch]); continue; } r -= E_CP;
        if (r < E_PP) { const int b = r / (15 * DPOOL), rem = r % (15 * DPOOL), j = rem / DPOOL, ch = rem % DPOOL; p.out[O_POOLP + r] = bf2f(PROJ[((size_t)b * SEQ + SEQ - 15 + j) * NPROJ + C_U + ch]); continue; } r -= E_PP;
        if (r < E_CS) { const int b = r / (3 * CONVD), rem = r % (3 * CONVD), j = rem / CONVD, ch = rem % CONVD; p.out[O_CONVS + r] = bf2f(PROJ[((size_t)NTOK_P + b * LS + LS - 3 + j) * NPROJ + C_XBC + ch]); continue; } r -= E_CS;
        { const int b = r / (15 * DPOOL), rem = r % (15 * DPOOL), j = rem / DPOOL, ch = rem % DPOOL;
          p.out[O_POOLS + r] = j < 7 ? p.st_pool[((size_t)b * 15 + 8 + j) * DPOOL + ch] : bf2f(PROJ[((size_t)NTOK_P + b * LS + (j - 7)) * NPROJ + C_U + ch]); }
    }
}

constexpr int IT_SSD = NB_P * NH, IT_POOL = MTOK / 128, IT_SMP = NB_S * NH / 8, IT_ALL = IT_SSD + IT_POOL + IT_SMP + N_COPY;
__device__ __forceinline__ void phase2(const Params& p, LAS unsigned char* lds, float ssq_scale) {
    unsigned* ctr = (unsigned*)(p.ws + WS_CTL);
    volatile LAS int* slot = (volatile LAS int*)(lds + OFF_MISC);
    for (;;) {
        __syncthreads();
        if (threadIdx.x == 0) slot[0] = (int)atomicAdd(ctr, 1u);
        __syncthreads();
        const int it = slot[0];
        if (it >= IT_ALL) break;
        if (it < IT_SSD) ssd_prompt_item(p, lds, it, ssq_scale);
        else if (it < IT_SSD + IT_POOL) pool_item(p, lds, it - IT_SSD);
        else if (it < IT_SSD + IT_POOL + IT_SMP) ssd_sample_wave(p, lds, (it - IT_SSD - IT_POOL) * 8 + (int)(threadIdx.x >> 6), ssq_scale);
        else copy_item(p, it - IT_SSD - IT_POOL - IT_SMP);
    }
}

__device__ __forceinline__ void phase5(const Params& p) {
    const int tid = threadIdx.x, lane = tid & 63, wave = tid >> 6; const int gw = blockIdx.x * 8 + wave, NGW = gridDim.x * 8;
    const bf16_t* OUTB = (const bf16_t*)(p.ws + WS_PROJ); const float* SSQ2 = (const float*)(p.ws + WS_SSQ2);
    for (int m = gw; m < MTOK; m += NGW) {
        const float* xrow = m < NTOK_P ? p.x_p + (size_t)m * DM : p.x_s + (size_t)(m - NTOK_P) * DM;
        float* yrow = m < NTOK_P ? p.out + O_YP + (size_t)m * DM : p.out + O_YS + (size_t)(m - NTOK_P) * DM;
        const float rstd = rsqrtf(SSQ2[m] * (1.f / DM) + EPS);
#pragma unroll
        for (int j = 0; j < 4; ++j) { const f32x4 x4 = ((const f32x4*)xrow)[lane + 64 * j], g4 = ((const f32x4*)p.norm_post)[lane + 64 * j]; const u32x2 o2 = ((const u32x2*)(OUTB + (size_t)m * DM))[lane + 64 * j];
            f32x4 y; y.x = x4.x + bf_lo(o2.x) * rstd * g4.x; y.y = x4.y + bf_hi(o2.x) * rstd * g4.y; y.z = x4.z + bf_lo(o2.y) * rstd * g4.z; y.w = x4.w + bf_hi(o2.y) * rstd * g4.w;
            ((f32x4*)yrow)[lane + 64 * j] = y; }
    }
}

#include <cstdlib>
#include <vector>

#define XB_TMO      128
#define XB_XCNT(j)  (256  + 64 * (j))
#define XB_XSUB(j)  (1280 + 64 * (j))
#define XB_XGEN(j)  (2304 + 64 * (j))
#define XB_TOP      3328
#define XB_TOPGEN   3392
#define XCD_BAR_WORDS 3456
#define XB_SPIN_CAP (1u << 18)

__device__ __forceinline__ unsigned xb_ld(unsigned* p)              { return __hip_atomic_load(p, __ATOMIC_RELAXED, __HIP_MEMORY_SCOPE_AGENT); }
__device__ __forceinline__ unsigned xb_add(unsigned* p, unsigned v) { return __hip_atomic_fetch_add(p, v, __ATOMIC_RELAXED, __HIP_MEMORY_SCOPE_AGENT); }
__device__ __forceinline__ unsigned xb_xcc_id() { return (unsigned)__builtin_amdgcn_s_getreg((3 << 11) | 20) & 0xFu; }
#define XB_SPIN(cond, bar) do { unsigned _sp = 0; while (cond) { __builtin_amdgcn_s_sleep(1); \
    if ((++_sp & 255u) == 0u) { if (xb_ld(&(bar)[XB_TMO])) break; if (_sp > XB_SPIN_CAP) { atomicAdd(&(bar)[XB_TMO], 1u); break; } } } } while (0)

struct XcdBarrier {
    unsigned* bar; unsigned x;
    volatile LAS unsigned* st;
};

__device__ __forceinline__ XcdBarrier xcd_barrier_post(unsigned* bar, volatile LAS unsigned* st) {
    XcdBarrier b; b.bar = bar; b.x = xb_xcc_id(); b.st = st;
    if (threadIdx.x == 0) (void)xb_add(&bar[XB_XCNT(b.x)], 1u);
    return b;
}
__device__ __forceinline__ void xcd_barrier_complete(unsigned* bar, unsigned x, unsigned& nloc, unsigned& nx) {
    const unsigned G = gridDim.x * gridDim.y * gridDim.z;
    unsigned sum, cnt, mine, sp = 0u;
    for (;;) {
        sum = 0u; cnt = 0u; mine = 0u;
#pragma unroll
        for (unsigned j = 0; j < 16; ++j) { const unsigned c = xb_ld(&bar[XB_XCNT(j)]); sum += c; cnt += (c > 0u) ? 1u : 0u; mine = (j == x) ? c : mine; }
        if (sum == G) break;
        __builtin_amdgcn_s_sleep(1);
        if ((++sp & 255u) == 0u) { if (xb_ld(&bar[XB_TMO])) break; if (sp > XB_SPIN_CAP) { atomicAdd(&bar[XB_TMO], 1u); break; } }
    }
    nloc = mine > 0u ? mine : 1u; nx = cnt > 0u ? cnt : 1u;
}

__device__ __forceinline__ void xcd_barrier(const XcdBarrier& b) {
    asm volatile("s_waitcnt vmcnt(0)" ::: "memory");
    __syncthreads();
    if (threadIdx.x == 0) {
        unsigned* bar = b.bar;
        __builtin_amdgcn_s_waitcnt(0);
        unsigned nloc = b.st[0], nx = b.st[1];
        if (nloc == 0u) { xcd_barrier_complete(bar, b.x, nloc, nx); b.st[0] = nloc; b.st[1] = nx; }
        const unsigned old = xb_add(&bar[XB_XSUB(b.x)], 1u);
        const unsigned gen = old / nloc;
        if (old + 1u == (gen + 1u) * nloc) {
            __builtin_amdgcn_fence(__ATOMIC_RELEASE, "agent");
            asm volatile("s_waitcnt vmcnt(0)" ::: "memory");
            const unsigned og = xb_add(&bar[XB_TOP], 1u);
            const unsigned tg = og / nx;
            if (og + 1u == (tg + 1u) * nx) xb_add(&bar[XB_TOPGEN], 1u);
            else XB_SPIN(xb_ld(&bar[XB_TOPGEN]) == tg, bar);
            __builtin_amdgcn_fence(__ATOMIC_ACQUIRE, "agent");
            xb_add(&bar[XB_XGEN(b.x)], 1u);
            asm volatile("s_waitcnt vmcnt(0)" ::: "memory");
        } else {
            XB_SPIN(xb_ld(&bar[XB_XGEN(b.x)]) == gen, bar);
            __builtin_amdgcn_fence(__ATOMIC_ACQUIRE, "agent");
            asm volatile("s_waitcnt vmcnt(0)" ::: "memory");
        }
    }
    __syncthreads();
}


__global__ void __launch_bounds__(512, 2) fwd_kernel(Params p) {
    extern __shared__ __attribute__((aligned(16))) unsigned char smem[];
    LAS unsigned char* lds = (LAS unsigned char*)smem;
    cg::grid_group grid = cg::this_grid();
    unsigned char* ws = p.ws;
    const int lo = p.ph_lo, hi = p.ph_hi;
#define IN(k) (lo <= (k) && (k) < hi)
    XcdBarrier xbar; xbar.bar = (unsigned*)(ws + WS_BAR); xbar.x = 0; xbar.st = (volatile LAS unsigned*)(lds + OFF_MISC + 16);
    const bool multi = hi - lo > 1;
    if (multi) {
        if (blockIdx.x == 0) { for (int i = threadIdx.x; i < XCD_BAR_WORDS; i += 512) xbar.bar[i] = 0u; }
        if (threadIdx.x == 0) { xbar.st[0] = 0u; xbar.st[1] = 0u; }
        __threadfence();
        grid.sync();
        xbar = xcd_barrier_post((unsigned*)(ws + WS_BAR), (volatile LAS unsigned*)(lds + OFF_MISC + 16));
    }
#define SEAM(k) do { if (IN(k) && IN((k) + 1)) xcd_barrier(xbar); } while (0)
    if (IN(0)) for (int rep = 0; rep < (REP_PHASE == 0 ? 2 : 1); ++rep) phase0(p, lds);
    SEAM(0);
    if (IN(1)) for (int rep = 0; rep < (REP_PHASE == 1 ? 2 : 1); ++rep) { pg8::Gemm g{(const bf16_t*)(p.out + O_YP), (const bf16_t*)(ws + WS_WIN), MTOK, NPROJ, DM}; pg8::StaticOrder S; S.init(MTOK, NPROJ, (int)gridDim.x, (int)blockIdx.x);
        pg8::EpiStore E{(bf16_t*)(ws + WS_PROJ), NPROJ}; pg8::gemm_phase<pg8::EpiStore, pg8::StaticOrder>(lds, g, S, E); }
    SEAM(1);
    if (IN(2)) for (int rep = 0; rep < (REP_PHASE == 2 ? 2 : 1); ++rep) phase_conv(p);
    SEAM(2);
    if (IN(3)) {
        if (REP_PHASE == 3) { phase2(p, lds, 0.f); xcd_barrier(xbar); if (blockIdx.x == 0 && threadIdx.x == 0) *(unsigned*)(ws + WS_CTL) = 0u; xcd_barrier(xbar); }
        phase2(p, lds, 1.f); }
    SEAM(3);
    if (IN(4)) for (int rep = 0; rep < (REP_PHASE == 4 ? 2 : 1); ++rep) { pg8::Gemm g{(const bf16_t*)(p.out + O_YP), (const bf16_t*)(ws + WS_WCAT), MTOK, DM, KCAT}; pg8::SegOrder S; S.init(MTOK, DM, (int)gridDim.x, (int)blockIdx.x);
        pg8::EpiMerge E{(const bf16_t*)(ws + WS_PROJ), (const float*)(ws + WS_SSQ), (bf16_t*)(ws + WS_MERGED)}; pg8::gemm_phase<pg8::EpiMerge, pg8::SegOrder>(lds, g, S, E); }
    SEAM(4);
    if (IN(5)) for (int rep = 0; rep < (REP_PHASE == 5 ? 2 : 1); ++rep) { pg8::Gemm g{(const bf16_t*)(ws + WS_MERGED), (const bf16_t*)(ws + WS_WOUT), MTOK, DM, DM}; pg8::StaticOrder S; S.init(MTOK, DM, (int)gridDim.x, (int)blockIdx.x);
        pg8::EpiOut E{(bf16_t*)(ws + WS_PROJ), (float*)(ws + WS_SSQ2), (REP_PHASE == 5 && rep == 0) ? 0.f : 1.f}; pg8::gemm_phase<pg8::EpiOut, pg8::StaticOrder>(lds, g, S, E); }
    SEAM(5);
    if (IN(6)) for (int rep = 0; rep < (REP_PHASE == 6 ? 2 : 1); ++rep) phase5(p);
    if (REP_PHASE == 40) { for (int i = 0; i < 10; ++i) xcd_barrier(xbar); }
}

#ifndef N_LAUNCH_MODE
#define N_LAUNCH_MODE 1
#endif
extern "C" void kernel_launch(void* const* d_in, const int* in_sizes, int n_in, void* d_out, int out_size, void* d_ws, size_t ws_size, hipStream_t stream) {
    static int grid = 0;
    if (grid == 0) {
        if (n_in != 19 || (size_t)out_size != O_END || ws_size < WS_END) { fprintf(stderr, "kernel_launch: unexpected sizes n_in %d out %d ws %zu (need %zu)\n", n_in, out_size, ws_size, (size_t)WS_END); grid = -1; return; }
        int dev = 0, cus = 0, per_cu = 0;
        hipGetDevice(&dev); hipDeviceGetAttribute(&cus, hipDeviceAttributeMultiprocessorCount, dev);
        if (hipFuncSetAttribute((const void*)fwd_kernel, hipFuncAttributeMaxDynamicSharedMemorySize, LDS_BYTES) != hipSuccess) { fprintf(stderr, "kernel_launch: hipFuncSetAttribute failed\n"); grid = -1; return; }
        if (hipOccupancyMaxActiveBlocksPerMultiprocessor(&per_cu, (const void*)fwd_kernel, 512, LDS_BYTES) != hipSuccess || per_cu < 1) { fprintf(stderr, "kernel_launch: occupancy query failed (%d)\n", per_cu); grid = -1; return; }
        grid = cus;
    }
    if (grid <= 0) return;
    Params p{};
    const float** f = (const float**)&p;
    for (int i = 0; i < 19; ++i) f[i] = (const float*)d_in[i];
    p.out = (float*)d_out; p.ws = (unsigned char*)d_ws;
    if (N_LAUNCH_MODE == 1) {
        p.ph_lo = 0; p.ph_hi = 7; void* args[] = {&p};
        hipError_t e = hipLaunchCooperativeKernel((const void*)fwd_kernel, dim3(grid), dim3(512), args, LDS_BYTES, stream);
        if (e != hipSuccess) fprintf(stderr, "cooperative launch failed: %s (grid %d)\n", hipGetErrorString(e), grid);
    } else {
        for (int ph = 0; ph < 7; ++ph) { p.ph_lo = ph; p.ph_hi = ph + 1; hipLaunchKernelGGL(fwd_kernel, dim3(grid), dim3(512), LDS_BYTES, stream, p); }
    }
}
```

```cpp
#include <hip/hip_runtime.h>
#include <hip/hip_cooperative_groups.h>
#include <cstdio>
#include <cstdint>
namespace cg = cooperative_groups;

#define LAS __attribute__((address_space(3)))
typedef unsigned short bf16_t;
typedef short bf16x8 __attribute__((ext_vector_type(8)));
typedef float f32x4 __attribute__((ext_vector_type(4)));
typedef float f32x2 __attribute__((ext_vector_type(2)));
typedef unsigned u32x4 __attribute__((ext_vector_type(4)));
typedef unsigned u32x2 __attribute__((ext_vector_type(2)));

constexpr int DM = 1024, SEQ = 2048, NB_P = 8, NB_S = 128, LS = 8;
constexpr int NTOK_P = NB_P * SEQ, NTOK_S = NB_S * LS, MTOK = NTOK_P + NTOK_S;
constexpr int NPROJ = 5632;
constexpr int C_Z = 0, C_XBC = 1024, C_U = 2560, C_G = 3072, C_GATE = 3584;
constexpr int DIN = 5648, CONVD = 1536, NH = 16, HD = 64, DS = 128, DPOOL = 512, KCAT = 1536;
constexpr float EPS = 1e-6f;

constexpr size_t WS_CTL = 0;
constexpr size_t WS_BAR = 4096;
constexpr size_t WS_SSQ = 4096 + 16384;
constexpr size_t WS_SSQ2 = WS_SSQ + (size_t)MTOK * 2 * 4;
constexpr size_t WS_DT = WS_SSQ2 + (size_t)MTOK * 4;
constexpr size_t WS_WIN = (WS_DT + (size_t)MTOK * 16 * 4 + 255) / 256 * 256;
constexpr size_t WS_WCAT = WS_WIN + (size_t)NPROJ * DM * 2;
constexpr size_t WS_WOUT = WS_WCAT + (size_t)DM * KCAT * 2;
constexpr size_t WS_PMIX = WS_WOUT + (size_t)DM * DM * 2;
constexpr size_t WS_PROJ = WS_PMIX + (size_t)4 * 128 * 128 * 2;
constexpr size_t WS_X = WS_PROJ + (size_t)MTOK * NPROJ * 2;
constexpr size_t WS_MERGED = WS_X;
constexpr size_t WS_END = WS_X + (size_t)MTOK * KCAT * 2;
static_assert(WS_END <= (size_t)256 * 1024 * 1024, "d_ws is only guaranteed to be 256 MiB");

constexpr size_t O_YP = 0, O_YS = O_YP + (size_t)NTOK_P * DM, O_CONVP = O_YS + (size_t)NTOK_S * DM, O_SSMP = O_CONVP + (size_t)NB_P * 3 * CONVD,
                 O_POOLP = O_SSMP + (size_t)NB_P * NH * HD * DS, O_CONVS = O_POOLP + (size_t)NB_P * 15 * DPOOL, O_SSMS = O_CONVS + (size_t)NB_S * 3 * CONVD,
                 O_POOLS = O_SSMS + (size_t)NB_S * NH * HD * DS, O_END = O_POOLS + (size_t)NB_S * 15 * DPOOL;

constexpr int LDS_BYTES = 147456;

struct Params {
    const float *x_p, *x_s, *st_conv, *st_ssm, *st_pool, *norm_pre, *w_in, *conv_w, *conv_b, *dt_bias, *a_log, *d_skip, *ssm_norm, *w_a, *pool_mix, *pool_scale, *w_b, *w_out, *norm_post;
    float* out; unsigned char* ws; int ph_lo, ph_hi;
};

__device__ __forceinline__ unsigned cvt_pk_bf16(float lo, float hi) { unsigned r; asm("v_cvt_pk_bf16_f32 %0, %1, %2" : "=v"(r) : "v"(lo), "v"(hi)); return r; }
__device__ __forceinline__ float bf_lo(unsigned u) { return __uint_as_float(u << 16); }
__device__ __forceinline__ float bf_hi(unsigned u) { return __uint_as_float(u & 0xffff0000u); }
__device__ __forceinline__ float bf2f(bf16_t v) { return __uint_as_float((unsigned)v << 16); }
__device__ __forceinline__ float silu_f(float v) { return v * __builtin_amdgcn_rcpf(1.f + __expf(-v)); }
__device__ __forceinline__ float wave_sum(float v) {
#pragma unroll
    for (int o = 1; o < 64; o <<= 1) v += __shfl_xor(v, o);
    return v;
}
#define LDS_WAIT() asm volatile("s_waitcnt lgkmcnt(0)" ::: "memory")
#define MFMA16(a, b, c) __builtin_amdgcn_mfma_f32_16x16x32_bf16((a), (b), (c), 0, 0, 0)

namespace pg8 {
#define PG8_LAS __attribute__((address_space(3)))
typedef unsigned short bf16_t;
typedef short bf16x8 __attribute__((ext_vector_type(8)));
typedef float f32x4 __attribute__((ext_vector_type(4)));
typedef unsigned u32x4 __attribute__((ext_vector_type(4)));
constexpr int BM = 256, BK = 64, HALF = 128, HTB = HALF * BK * 2  , STAGE_BYTES = 8 * HTB, NXCD = 8, WGM = 8;

__host__ __device__ __forceinline__ int lds_byte(int r, int c) { const int st = (r >> 4) * 2 + (c >> 5), rr = r & 15, cc = c & 31, ob = rr * 64 + cc * 2; return st * 1024 + (ob ^ (((ob >> 9) & 1) << 5)); }
__host__ __device__ __forceinline__ void stage_rc(int b, int& R, int& C) { const int st = b / 1024, sb = b % 1024, swz = sb ^ (((sb >> 9) & 1) << 5); R = (st >> 1) * 16 + swz / 64; C = (st & 1) * 32 + (swz % 64) / 2; }
__host__ __device__ __forceinline__ int perm32(int rho) { const int n = rho >> 4, i = rho & 15; return 8 * (i >> 2) + 4 * n + (i & 3); }

struct Unit { int pm, pn, seg; };
struct Gemm { const bf16_t* A; const bf16_t* Bt; int M, N, K; };

struct StaticOrder {
    int nM, nN, nwg, G, c;
    __host__ __device__ void init(int M, int N, int G_, int c_) { nM = M / BM; nN = N / BM; nwg = nM * nN; G = G_; c = c_; }
    __host__ __device__ bool next(int i, Unit& u) const {
        const long L = (long)i * G + c; if (L >= nwg) return false;
        int wgid = (int)L; { const int q = nwg / NXCD, r = nwg % NXCD, xcd = wgid % NXCD, off = wgid / NXCD; wgid = (xcd < r ? xcd * (q + 1) : r * (q + 1) + (xcd - r) * q) + off; }
        const int nig = WGM * nN, gid = wgid / nig, fm = gid * WGM, gsz = (nM - fm) < WGM ? (nM - fm) : WGM;
        u.pm = fm + ((wgid % nig) % gsz); u.pn = (wgid % nig) / gsz; u.seg = 0; return true;
    }
    __device__ __forceinline__ void a_ready(const Unit&) const {}
    __device__ __forceinline__ void done(const Unit&) const {}
};

struct SegOrder : StaticOrder {
    __host__ __device__ bool next(int i, Unit& u) const { const bool ok = StaticOrder::next(i / 3, u); u.seg = i % 3; return ok; }
};

struct EpiStore {
    static constexpr bool PERM = true, AFTER_DRAIN = false, HOOKS = false;
    bf16_t* O; int ldc;
    __device__ __forceinline__ void operator()(const f32x4 (&acc)[2][2][4][2], const Unit& u, int wr, int wc, int fr, int fq) const {
        const int row0 = u.pm * BM + wr * 64 + fr;
        if (u.pn < 14) {
            const int col0 = u.pn * BM + wc * 32 + 8 * fq;
#pragma unroll
            for (int ai = 0; ai < 2; ++ai)
#pragma unroll
                for (int m = 0; m < 4; ++m) { bf16_t* rowp = O + (size_t)(row0 + ai * HALF + m * 16) * ldc + col0;
#pragma unroll
                    for (int bj = 0; bj < 2; ++bj) { const f32x4 v0 = acc[ai][bj][m][0], v1 = acc[ai][bj][m][1];
                        u32x4 w; w.x = ::cvt_pk_bf16(v0[0], v0[1]); w.y = ::cvt_pk_bf16(v0[2], v0[3]); w.z = ::cvt_pk_bf16(v1[0], v1[1]); w.w = ::cvt_pk_bf16(v1[2], v1[3]);
                        *(u32x4*)(rowp + bj * HALF) = w; } }
        } else {
            const int d0 = ::C_GATE + (u.pn - 14) * HALF + wc * 32 + 8 * fq;
#pragma unroll
            for (int ai = 0; ai < 2; ++ai)
#pragma unroll
                for (int m = 0; m < 4; ++m) { bf16_t* rowp = O + (size_t)(row0 + ai * HALF + m * 16) * ldc + d0; float f1[8], f2[8];
#pragma unroll
                    for (int idx = 0; idx < 8; ++idx) { const float ga = acc[ai][0][m][idx >> 2][idx & 3], gb = acc[ai][1][m][idx >> 2][idx & 3];
                        const float ea = 1.f + __expf(-ga), eb = 1.f + __expf(-gb); f1[idx] = eb * __builtin_amdgcn_rcpf(ea); f2[idx] = __builtin_amdgcn_rcpf(eb); }
                    u32x4 w; w.x = ::cvt_pk_bf16(f1[0], f1[1]); w.y = ::cvt_pk_bf16(f1[2], f1[3]); w.z = ::cvt_pk_bf16(f1[4], f1[5]); w.w = ::cvt_pk_bf16(f1[6], f1[7]);
                    *(u32x4*)rowp = w;
                    w.x = ::cvt_pk_bf16(f2[0], f2[1]); w.y = ::cvt_pk_bf16(f2[2], f2[3]); w.z = ::cvt_pk_bf16(f2[4], f2[5]); w.w = ::cvt_pk_bf16(f2[6], f2[7]);
                    *(u32x4*)(rowp + 1024) = w; }
        }
    }
};
struct EpiMerge {
    static constexpr bool PERM = true, AFTER_DRAIN = false, HOOKS = true;
    const bf16_t* proj; const float* ssq; bf16_t* O;
    __device__ __forceinline__ void operator()(f32x4 (&acc)[2][2][4][2], const Unit& u, int wr, int wc, int fr, int fq) const {
        int row0 = u.pm * BM + wr * 64 + fr, col0 = u.pn * BM + wc * 32 + 8 * fq;
        asm volatile("" : "+v"(row0), "+v"(col0));
        const int seg = u.seg; const char* pb = (const char*)proj + (seg == 2 ? 2048 : 0);
        u32x4 rg[4];
#define EM_ROW(g) (row0 + ((g) >> 3) * HALF + (((g) >> 1) & 3) * 16)
#define EM_LOAD(g) do { rg[(g) & 3] = *(const u32x4*)(pb + ((unsigned)EM_ROW(g) * (unsigned)::NPROJ + (unsigned)(::C_GATE + col0)) * 2u + ((g) & 1) * 256); } while (0)
#pragma unroll
        for (int g = 0; g < 4; ++g) rg[g] = (u32x4){0u, 0u, 0u, 0u};
        if (seg != 0) {
#pragma unroll
            for (int g = 0; g < 4; ++g) EM_LOAD(g); }
        ::f32x2 sq[8];
#pragma unroll
        for (int h = 0; h < 8; ++h) sq[h] = (::f32x2){1.f, 1.f};
        if (seg != 2) {
#pragma unroll
            for (int h = 0; h < 8; ++h) sq[h] = *(const ::f32x2*)((const char*)ssq + (unsigned)EM_ROW(2 * h) * 8u); }
#pragma unroll
        for (int g = 0; g < 16; ++g) { const int ai = g >> 3, m = (g >> 1) & 3, bj = g & 1; const int row = EM_ROW(g);
            const ::f32x2 s = sq[g >> 1]; const float q1 = s.y * (1.f / 512.f) + ::EPS, r1 = rsqrtf(q1), rr = rsqrtf(s.x * (1.f / 512.f) + ::EPS) * __builtin_amdgcn_sqrtf(q1);
            const float rowf = seg == 0 ? rr : (seg == 1 ? r1 : 1.f);
            const u32x4 gf = rg[g & 3]; float v[8];
#pragma unroll
            for (int idx = 0; idx < 8; ++idx) { const unsigned wf = gf[idx >> 1]; const float fv = (idx & 1) ? ::bf_hi(wf) : ::bf_lo(wf);
                const float f = seg == 0 ? rowf : rowf * fv;
                v[idx] = acc[ai][bj][m][idx >> 2][idx & 3] * f; }
            if (seg == 2) { u32x4 w; w.x = ::cvt_pk_bf16(v[0], v[1]); w.y = ::cvt_pk_bf16(v[2], v[3]); w.z = ::cvt_pk_bf16(v[4], v[5]); w.w = ::cvt_pk_bf16(v[6], v[7]);
                *(u32x4*)((char*)O + ((unsigned)row * (unsigned)::DM + (unsigned)col0) * 2u + bj * 256) = w; }
            const float keep = seg == 2 ? 0.f : 1.f;
            acc[ai][bj][m][0] = (f32x4){v[0], v[1], v[2], v[3]} * keep; acc[ai][bj][m][1] = (f32x4){v[4], v[5], v[6], v[7]} * keep;
            if (g + 4 < 16 && seg != 0) EM_LOAD(g + 4);
            asm volatile("" : "+v"(acc[ai][bj][m][0]), "+v"(acc[ai][bj][m][1]) :: "memory"); }
#undef EM_LOAD
#undef EM_ROW
    }
};
struct EpiOut {
    static constexpr bool PERM = true, AFTER_DRAIN = false, HOOKS = false;
    bf16_t* O; float* ssq2; float scale;
    __device__ __forceinline__ void operator()(const f32x4 (&acc)[2][2][4][2], const Unit& u, int wr, int wc, int fr, int fq) const {
        const int row0 = u.pm * BM + wr * 64 + fr, col0 = u.pn * BM + wc * 32 + 8 * fq;
#pragma unroll
        for (int ai = 0; ai < 2; ++ai)
#pragma unroll
            for (int m = 0; m < 4; ++m) { const int row = row0 + ai * HALF + m * 16; float ss = 0.f;
#pragma unroll
                for (int bj = 0; bj < 2; ++bj) { const f32x4 v0 = acc[ai][bj][m][0], v1 = acc[ai][bj][m][1];
                    ss += (v0[0] * v0[0] + v0[1] * v0[1]) + (v0[2] * v0[2] + v0[3] * v0[3]) + (v1[0] * v1[0] + v1[1] * v1[1]) + (v1[2] * v1[2] + v1[3] * v1[3]);
                    u32x4 w; w.x = ::cvt_pk_bf16(v0[0], v0[1]); w.y = ::cvt_pk_bf16(v0[2], v0[3]); w.z = ::cvt_pk_bf16(v1[0], v1[1]); w.w = ::cvt_pk_bf16(v1[2], v1[3]);
                    *(u32x4*)(O + (size_t)row * ::DM + col0 + bj * HALF) = w; }
                ss += __shfl_xor(ss, 16); ss += __shfl_xor(ss, 32);
                if (fq == 0) atomicAdd(ssq2 + row, ss * scale); }
    }
};

template <class Epi, class Sched>
__device__ __forceinline__ void gemm_phase(PG8_LAS unsigned char* lds, const Gemm g, const Sched& S, const Epi& E) {
    const int tid = threadIdx.x, wid = __builtin_amdgcn_readfirstlane(tid >> 6), lane = tid & 63, wr = wid >> 2, wc = wid & 3, fr = lane & 15, fq = lane >> 4;
    const int K = g.K, nt = Epi::HOOKS ? 8 : K / BK;
    unsigned voffA[2], voffB[2];
#pragma unroll
    for (int i = 0; i < 2; ++i) { int R, C; stage_rc(tid * 16 + i * 8192, R, C); const int Rb = Epi::PERM ? ((R & ~31) + perm32(R & 31)) : R;
        voffA[i] = (unsigned)(R * K + C) * 2u; voffB[i] = (unsigned)(Rb * K + C) * 2u; }
    const size_t kstep = (size_t)(BK * 2);
    const size_t hstep = (size_t)HALF * K * 2;
    const size_t tstep = 2 * hstep;
    const unsigned ldsw = (unsigned)wid * 1024u;
    const int aoff = lds_byte(wr * 64 + fr, fq * 8), boff = lds_byte(wc * 32 + fr, fq * 8);
#define PG8_SA(b, h) (((b) * 2 + (h)) * HTB)
#define PG8_SB(b, h) ((4 + (b) * 2 + (h)) * HTB)
#define PG8_STAGE(bufoff, gbase, voff) do { _Pragma("unroll") for (int _i = 0; _i < 2; ++_i) \
        __builtin_amdgcn_global_load_lds((const unsigned*)((const char*)(gbase) + (voff)[_i]), (PG8_LAS unsigned*)(lds + (bufoff) + ldsw + _i * 8192), 16, 0, 0); } while (0)
#define PG8_LDA(dst, b, h) do { _Pragma("unroll") for (int m = 0; m < 4; ++m) _Pragma("unroll") for (int k = 0; k < 2; ++k) dst[m][k] = *(const PG8_LAS bf16x8*)(lds + PG8_SA(b, h) + aoff + m * 2048 + k * 1024); } while (0)
#define PG8_LDB(dst, b, h) do { _Pragma("unroll") for (int n = 0; n < 2; ++n) _Pragma("unroll") for (int k = 0; k < 2; ++k) dst[n][k] = *(const PG8_LAS bf16x8*)(lds + PG8_SB(b, h) + boff + n * 2048 + k * 1024); } while (0)
#define PG8_MMA(ai, bj, At, Bt) do { __builtin_amdgcn_s_setprio(1); _Pragma("unroll") for (int m = 0; m < 4; ++m) _Pragma("unroll") for (int n = 0; n < 2; ++n) _Pragma("unroll") for (int k = 0; k < 2; ++k) \
        acc[ai][bj][m][n] = __builtin_amdgcn_mfma_f32_16x16x32_bf16(Bt[n][k], At[m][k], acc[ai][bj][m][n], 0, 0, 0); __builtin_amdgcn_s_setprio(0); } while (0)
#define PG8_WAIT_V(n) asm volatile("s_waitcnt vmcnt(" #n ")" ::: "memory")
#define PG8_WAIT_L(n) asm volatile("s_waitcnt lgkmcnt(" #n ")" ::: "memory")
#define PG8_BAR __builtin_amdgcn_s_barrier()
#define PG8_SCHED __builtin_amdgcn_sched_barrier(0)
    Unit cur, nxt; int ui = 0;
    if (!S.next(0, cur)) return;
    f32x4 acc[2][2][4][2];
#pragma unroll
    for (int a = 0; a < 2; ++a)
#pragma unroll
        for (int b = 0; b < 2; ++b)
#pragma unroll
            for (int m = 0; m < 4; ++m)
#pragma unroll
                for (int n = 0; n < 2; ++n) acc[a][b][m][n] = (f32x4){0.f, 0.f, 0.f, 0.f};
    bf16x8 At[4][2], B0[2][2], B1[2][2];
    const char* cA = (const char*)g.A + (size_t)cur.pm * tstep + (Epi::HOOKS ? cur.seg * 1024 : 0); const char* cB = (const char*)g.Bt + (size_t)cur.pn * tstep + (Epi::HOOKS ? cur.seg * 1024 : 0);
    S.a_ready(cur);
    PG8_STAGE(PG8_SB(0, 0), cB, voffB); PG8_STAGE(PG8_SA(0, 0), cA, voffA); PG8_STAGE(PG8_SB(0, 1), cB + hstep, voffB); PG8_STAGE(PG8_SA(0, 1), cA + hstep, voffA);
    if (wr == 1) PG8_BAR;
    PG8_WAIT_V(4); PG8_BAR;
    PG8_STAGE(PG8_SB(1, 0), cB + kstep, voffB); PG8_STAGE(PG8_SA(1, 0), cA + kstep, voffA); PG8_STAGE(PG8_SB(1, 1), cB + hstep + kstep, voffB);
    PG8_WAIT_V(6); PG8_BAR;
    for (;;) {
        const bool has_next = S.next(ui + 1, nxt);
        const char* nA = has_next ? (const char*)g.A + (size_t)nxt.pm * tstep + (Epi::HOOKS ? nxt.seg * 1024 : 0) : cA; const char* nB = has_next ? (const char*)g.Bt + (size_t)nxt.pn * tstep + (Epi::HOOKS ? nxt.seg * 1024 : 0) : cB;
        for (int t = 0; t < nt; t += 2) {
            const bool last = (t == nt - 2);
            const char* a1 = cA + (size_t)(t + 1) * kstep;
            const char* a2 = last ? nA : cA + (size_t)(t + 2) * kstep; const char* b2 = last ? nB : cB + (size_t)(t + 2) * kstep;
            const char* a3 = a2 + kstep; const char* b3 = b2 + kstep;
            if (last && has_next) S.a_ready(nxt);
            PG8_LDB(B0, 0, 0); PG8_SCHED; PG8_LDA(At, 0, 0); PG8_STAGE(PG8_SA(1, 1), a1 + hstep, voffA);
            PG8_WAIT_L(8); PG8_BAR; PG8_WAIT_L(0); PG8_MMA(0, 0, At, B0); PG8_BAR; PG8_SCHED;
            PG8_LDB(B1, 0, 1); PG8_STAGE(PG8_SB(0, 0), b2, voffB);
            PG8_BAR; PG8_WAIT_L(0); PG8_MMA(0, 1, At, B1); PG8_BAR;
            PG8_LDA(At, 0, 1); PG8_STAGE(PG8_SA(0, 0), a2, voffA);
            PG8_BAR; PG8_WAIT_L(0); PG8_MMA(1, 0, At, B0); PG8_BAR; PG8_SCHED;
            PG8_STAGE(PG8_SB(0, 1), b2 + hstep, voffB);
            PG8_WAIT_V(6); PG8_BAR; PG8_MMA(1, 1, At, B1); PG8_BAR;
            PG8_LDB(B0, 1, 0); PG8_SCHED; PG8_LDA(At, 1, 0); PG8_STAGE(PG8_SA(0, 1), a2 + hstep, voffA);
            PG8_WAIT_L(8); PG8_BAR; PG8_WAIT_L(0); PG8_MMA(0, 0, At, B0); PG8_BAR; PG8_SCHED;
            PG8_LDB(B1, 1, 1); PG8_STAGE(PG8_SB(1, 0), b3, voffB);
            PG8_BAR; PG8_WAIT_L(0); PG8_MMA(0, 1, At, B1); PG8_BAR;
            PG8_LDA(At, 1, 1); PG8_STAGE(PG8_SA(1, 0), a3, voffA);
            PG8_BAR; PG8_WAIT_L(0); PG8_MMA(1, 0, At, B0); PG8_BAR; PG8_SCHED;
            PG8_STAGE(PG8_SB(1, 1), b3 + hstep, voffB);
            PG8_WAIT_V(6); PG8_BAR; PG8_MMA(1, 1, At, B1); PG8_BAR;
        }
        if constexpr (!Epi::AFTER_DRAIN) { E(acc, cur, wr, wc, fr, fq); S.done(cur); }
        if (!has_next) break;
        if (!Epi::HOOKS)
#pragma unroll
        for (int a = 0; a < 2; ++a)
#pragma unroll
            for (int b = 0; b < 2; ++b)
#pragma unroll
                for (int m = 0; m < 4; ++m)
#pragma unroll
                    for (int n = 0; n < 2; ++n) acc[a][b][m][n] = (f32x4){0.f, 0.f, 0.f, 0.f};
        cur = nxt; cA = nA; cB = nB; ++ui;
    }
    PG8_WAIT_V(0);
    if (wr == 0) PG8_BAR;
    PG8_BAR;
    if constexpr (Epi::AFTER_DRAIN) { E.fused(acc, cur, wr, wc, fr, fq, lds, wid, lane); S.done(cur); }
#undef PG8_SA
#undef PG8_SB
#undef PG8_STAGE
#undef PG8_LDA
#undef PG8_LDB
#undef PG8_MMA
#undef PG8_WAIT_V
#undef PG8_WAIT_L
#undef PG8_BAR
#undef PG8_SCHED
}
}

#ifndef REP_PHASE
#define REP_PHASE -1
#endif

__device__ __forceinline__ void tr_item(const float* __restrict__ W, int ldw, int k0, int c0, bf16_t* WT, int ldt, int d0, int kd0, const float* __restrict__ kscale, LAS float* scr, int lane) {
#pragma unroll
    for (int i = 0; i < 32; ++i) { const int kk = 2 * i + (lane >> 5); float v = W[(size_t)(k0 + kk) * ldw + c0 + (lane & 31)]; if (kscale) v *= kscale[k0 + kk]; scr[kk * 33 + (lane & 31)] = v; }
    LDS_WAIT();
    const int c = lane & 7;
#pragma unroll
    for (int j = 0; j < 4; ++j) { const int n = (lane >> 3) + 8 * j; const LAS float* s = scr + (8 * c) * 33 + n;
        u32x4 o; o.x = cvt_pk_bf16(s[0], s[33]); o.y = cvt_pk_bf16(s[66], s[99]); o.z = cvt_pk_bf16(s[132], s[165]); o.w = cvt_pk_bf16(s[198], s[231]);
        *(u32x4*)(WT + (size_t)(d0 + n) * ldt + kd0 + 8 * c) = o; }
    LDS_WAIT();
}

__device__ __forceinline__ void phase0(const Params& p, LAS unsigned char* lds) {
    const int tid = threadIdx.x, lane = tid & 63, wave = tid >> 6, G = gridDim.x;
    const int gw = blockIdx.x * 8 + wave, NGW = G * 8;
    unsigned char* ws = p.ws;
    bf16_t* WIN = (bf16_t*)(ws + WS_WIN); bf16_t* WCAT = (bf16_t*)(ws + WS_WCAT); bf16_t* WOUT = (bf16_t*)(ws + WS_WOUT); bf16_t* PMIX = (bf16_t*)(ws + WS_PMIX);
    bf16_t* HB = (bf16_t*)(p.out + O_YP); float* DT = (float*)(ws + WS_DT);
    { float* z = (float*)(ws + WS_SSQ); for (int i = blockIdx.x * 512 + tid; i < 3 * MTOK; i += G * 512) z[i] = 0.f;
      if (blockIdx.x == 0 && tid == 0) *(unsigned*)(ws + WS_CTL) = 0u; }
    LAS float* wdt = (LAS float*)lds;
    for (int e = tid; e < 4096; e += 512) { const int k = e >> 2, j4 = e & 3; const f32x4 v = *(const f32x4*)(p.w_in + (size_t)k * DIN + 2560 + 4 * j4);
        wdt[(4 * j4 + 0) * 1024 + k] = v.x; wdt[(4 * j4 + 1) * 1024 + k] = v.y; wdt[(4 * j4 + 2) * 1024 + k] = v.z; wdt[(4 * j4 + 3) * 1024 + k] = v.w; }
    LAS float* scr = (LAS float*)(lds + 65536 + wave * 8448);
    constexpr int I_IN = 16 * 176, I_A = 16 * 32, I_B = 8 * 32, I_O = 16 * 32, I_P = 4 * 8, NIT = I_IN + I_A + I_B + I_O + I_P;
    for (int it = gw; it < NIT; it += NGW) {
        int r = it;
        if (r < I_IN) { const int kb = r / 176, nb = r % 176, d0 = 32 * nb, gc = (d0 - C_GATE) & 255, c0 = d0 < 2560 ? d0 : (d0 < C_GATE ? d0 + 16 : 3600 + ((d0 - C_GATE) >> 8) * 128 + (gc < 128 ? gc : 1024 + gc - 128)); tr_item(p.w_in, DIN, 64 * kb, c0, WIN, 1024, d0, 64 * kb, nullptr, scr, lane); continue; } r -= I_IN;
        if (r < I_A) { const int kb = r >> 5, nb = r & 31; tr_item(p.w_a, 1024, 64 * kb, 32 * nb, WCAT, KCAT, 32 * nb, 64 * kb, p.ssm_norm, scr, lane); continue; } r -= I_A;
        if (r < I_B) { const int kb = r >> 5, nb = r & 31; tr_item(p.w_b, 1024, 64 * kb, 32 * nb, WCAT, KCAT, 32 * nb, 1024 + 64 * kb, nullptr, scr, lane); continue; } r -= I_B;
        if (r < I_O) { const int kb = r >> 5, nb = r & 31; tr_item(p.w_out, 1024, 64 * kb, 32 * nb, WOUT, 1024, 32 * nb, 64 * kb, nullptr, scr, lane); continue; } r -= I_O;
        { const int k = r >> 3, kb = (r >> 2) & 1, nb = r & 3; tr_item(p.pool_mix + (size_t)k * 16384, 128, 64 * kb, 32 * nb, PMIX + (size_t)k * 16384, 128, 32 * nb, 64 * kb, nullptr, scr, lane); }
    }
    __syncthreads();
    const int jmine = (lane & 1) * 8 + ((lane >> 1) & 1) * 4 + ((lane >> 2) & 1) * 2 + ((lane >> 3) & 1);
    const float dtb = p.dt_bias[jmine];
    f32x4 g4[4];
#pragma unroll
    for (int j = 0; j < 4; ++j) g4[j] = ((const f32x4*)p.norm_pre)[lane + 64 * j];
    f32x4 nx[4];
    { const int m = gw; if (m < MTOK) { const float* xrow = m < NTOK_P ? p.x_p + (size_t)m * DM : p.x_s + (size_t)(m - NTOK_P) * DM;
#pragma unroll
        for (int j = 0; j < 4; ++j) nx[j] = ((const f32x4*)xrow)[lane + 64 * j]; } }
    for (int m = gw; m < MTOK; m += NGW) {
        f32x4 v[4]; float ss = 0.f;
#pragma unroll
        for (int j = 0; j < 4; ++j) { v[j] = nx[j]; ss += (v[j].x * v[j].x + v[j].y * v[j].y) + (v[j].z * v[j].z + v[j].w * v[j].w); }
        { const int m2 = m + NGW; if (m2 < MTOK) { const float* xrow = m2 < NTOK_P ? p.x_p + (size_t)m2 * DM : p.x_s + (size_t)(m2 - NTOK_P) * DM;
#pragma unroll
            for (int j = 0; j < 4; ++j) nx[j] = ((const f32x4*)xrow)[lane + 64 * j]; } }
        const float rstd = rsqrtf(wave_sum(ss) * (1.f / DM) + EPS);
        unsigned long long* o8 = (unsigned long long*)(HB + (size_t)m * DM);
#pragma unroll
        for (int j = 0; j < 4; ++j) { v[j] = v[j] * rstd * g4[j];
            o8[lane + 64 * j] = (unsigned long long)cvt_pk_bf16(v[j].x, v[j].y) | ((unsigned long long)cvt_pk_bf16(v[j].z, v[j].w) << 32); }
        float d[16];
#pragma unroll
        for (int jj = 0; jj < 16; ++jj) { float s = 0.f;
#pragma unroll
            for (int j = 0; j < 4; ++j) { const f32x4 w4 = *(const LAS f32x4*)(wdt + jj * 1024 + 4 * lane + 256 * j); s += (v[j].x * w4.x + v[j].y * w4.y) + (v[j].z * w4.z + v[j].w * w4.w); }
            d[jj] = s; }
#pragma unroll
        for (int i = 0; i < 8; ++i) { const bool hi = lane & 1; const float send = hi ? d[i] : d[i + 8], keep = hi ? d[i + 8] : d[i]; d[i] = keep + __shfl_xor(send, 1); }
#pragma unroll
        for (int i = 0; i < 4; ++i) { const bool hi = lane & 2; const float send = hi ? d[i] : d[i + 4], keep = hi ? d[i + 4] : d[i]; d[i] = keep + __shfl_xor(send, 2); }
#pragma unroll
        for (int i = 0; i < 2; ++i) { const bool hi = lane & 4; const float send = hi ? d[i] : d[i + 2], keep = hi ? d[i + 2] : d[i]; d[i] = keep + __shfl_xor(send, 4); }
        { const bool hi = lane & 8; const float send = hi ? d[0] : d[1], keep = hi ? d[1] : d[0]; d[0] = keep + __shfl_xor(send, 8); }
        float mine = d[0]; mine += __shfl_xor(mine, 16); mine += __shfl_xor(mine, 32);
        if (lane < 16) { const float a = mine + dtb; DT[(size_t)m * 16 + jmine] = a > 20.f ? a : log1pf(__expf(a)); }
    }
}

__device__ __forceinline__ void phase_conv(const Params& p) {
    const bf16_t* PROJ = (const bf16_t*)(p.ws + WS_PROJ); bf16_t* ACT = (bf16_t*)(p.ws + WS_X);
    const int T = gridDim.x * 512, gt = blockIdx.x * 512 + threadIdx.x;
    constexpr int NCP = CONVD / 2, NU = (MTOK / 8) * NCP;
    for (int u = gt; u < NU; u += T) {
        const int cp = u % NCP, ru = u / NCP, row0 = ru * 8, ch = 2 * cp;
        float w[4][2], in0[11], in1[11];
#pragma unroll
        for (int k = 0; k < 4; ++k) { const f32x2 t = *(const f32x2*)(p.conv_w + k * CONVD + ch); w[k][0] = t.x; w[k][1] = t.y; }
        const f32x2 bias = *(const f32x2*)(p.conv_b + ch);
        const bool prompt = row0 < NTOK_P; const int tb = row0 & (SEQ - 1), sb = (row0 - NTOK_P) >> 3;
        const bf16_t* col = PROJ + (size_t)row0 * NPROJ + C_XBC + ch;
#pragma unroll
        for (int i = 0; i < 11; ++i) {
            if (i >= 3 || (prompt && tb > 0)) { const unsigned v = *(const unsigned*)(col + (ptrdiff_t)(i - 3) * NPROJ); in0[i] = bf_lo(v); in1[i] = bf_hi(v); }
            else if (prompt) { in0[i] = 0.f; in1[i] = 0.f; }
            else { const f32x2 t = *(const f32x2*)(p.st_conv + ((size_t)sb * 3 + i) * CONVD + ch); in0[i] = t.x; in1[i] = t.y; }
        }
#pragma unroll
        for (int i = 0; i < 8; ++i) { float v0 = bias.x, v1 = bias.y;
#pragma unroll
            for (int k = 0; k < 4; ++k) { v0 += w[k][0] * in0[i + k]; v1 += w[k][1] * in1[i + k]; }
            *(unsigned*)(ACT + (size_t)(row0 + i) * KCAT + ch) = cvt_pk_bf16(silu_f(v0), silu_f(v1)); }
    }
}

constexpr int PIT = 272;
constexpr int OFF_C = 0, OFF_B = 34816, OFF_BT = 69632, OFF_XT = 104448, OFF_H = 121856, OFF_SM = 139264, OFF_MISC = OFF_SM + 2048, OFF_SM2 = OFF_MISC + 256;
static_assert(OFF_SM2 + 2048 <= LDS_BYTES, "lds");

#define LBAR() do { asm volatile("s_waitcnt lgkmcnt(0)" ::: "memory"); __builtin_amdgcn_s_barrier(); asm volatile("" ::: "memory"); } while (0)
#define SSD_SCAN(cn) do { LAS float* dts_ = (LAS float*)(lds + (((cn) & 1) ? OFF_SM2 : OFF_SM)); LAS float* acs_ = dts_ + 128; LAS float* wsd_ = dts_ + 256; \
        const float d0 = dtn0, d1 = dtn1, v0 = d0 * a_h, v1 = d1 * a_h; \
        if ((cn) + 1 < SEQ / 128) { dtn0 = DT[(row00 + (size_t)((cn) + 1) * 128 + 2 * lane) * 16 + head]; dtn1 = DT[(row00 + (size_t)((cn) + 1) * 128 + 2 * lane + 1) * 16 + head]; } \
        float x = v0 + v1; \
        _Pragma("unroll") for (int o = 1; o < 64; o <<= 1) { const float t = __shfl_up(x, o); if (lane >= o) x += t; } \
        const float tot = __shfl(x, 63), a1 = x, a0 = x - v1; \
        dts_[2 * lane] = d0; dts_[2 * lane + 1] = d1; acs_[2 * lane] = a0; acs_[2 * lane + 1] = a1; \
        wsd_[2 * lane] = d0 * __expf(tot - a0); wsd_[2 * lane + 1] = d1 * __expf(tot - a1); \
        if (lane == 0) dts_[384] = __expf(tot); } while (0)
__device__ __forceinline__ void ssd_prompt_item(const Params& p, LAS unsigned char* lds, int item, float ssq_scale) {
    int tid_ = threadIdx.x; asm volatile("" : "+v"(tid_));
    const int tid = tid_, wid = __builtin_amdgcn_readfirstlane(tid >> 6), lane = tid & 63, r = lane & 15, q = lane >> 4;
    const int b = item >> 4, head = item & 15, g = head >> 3;
    const bf16_t* PROJ = (const bf16_t*)(p.ws + WS_PROJ); const bf16_t* ACT = (const bf16_t*)(p.ws + WS_X); const float* DT = (const float*)(p.ws + WS_DT); float* SSQ = (float*)(p.ws + WS_SSQ);
    bf16_t* YCAT = (bf16_t*)(p.out + O_YP);
    const float a_h = -__expf(p.a_log[head]), Dh = p.d_skip[head];
    const int xp = tid & 31, xseg = tid >> 5, bp = tid & 63, bseg = tid >> 6, cg8 = tid & 15, ct = tid >> 4;
    const size_t row00 = (size_t)b * SEQ;
    const bf16_t* xcol = ACT + (row00 + xseg * 8) * KCAT + head * 64 + 2 * xp;
    const bf16_t* bcol = ACT + (row00 + bseg * 16) * KCAT + 1024 + g * 128 + 2 * bp;
    const bf16_t* ccol = ACT + (row00 + ct) * KCAT + 1280 + g * 128 + 8 * cg8;
    f32x4 hacc[4];
#pragma unroll
    for (int i = 0; i < 4; ++i) hacc[i] = (f32x4){0.f, 0.f, 0.f, 0.f};
    for (int i = tid; i < 17408 / 4; i += 512) ((LAS unsigned*)(lds + OFF_H))[i] = 0u;
    float dtn0 = 0.f, dtn1 = 0.f;
    if (wid == 0) { dtn0 = DT[(row00 + 2 * lane) * 16 + head]; dtn1 = DT[(row00 + 2 * lane + 1) * 16 + head]; }
    unsigned px[8], pbv[16]; u32x4 pc[4];
#define SSD_ISSUE(c) do { const size_t ro_ = (size_t)(c) * 128 * KCAT; \
        _Pragma("unroll") for (int i = 0; i < 8; ++i) px[i] = *(const unsigned*)(xcol + ro_ + (size_t)i * KCAT); \
        _Pragma("unroll") for (int i = 0; i < 16; ++i) pbv[i] = *(const unsigned*)(bcol + ro_ + (size_t)i * KCAT); \
        _Pragma("unroll") for (int i = 0; i < 4; ++i) pc[i] = *(const u32x4*)(ccol + ro_ + (size_t)(32 * i) * KCAT); } while (0)
    SSD_ISSUE(0);
    const int lt = wid < 4 ? 7 - wid : wid - 4, l0 = 16 * lt;
    if (wid == 0) SSD_SCAN(0);
    __syncthreads();
    for (int c = 0; c < SEQ / 128; ++c) {
        const size_t rowb = row00 + (size_t)c * 128;
        LAS float* dts = (LAS float*)(lds + ((c & 1) ? OFF_SM2 : OFF_SM)); LAS float* acs = dts + 128; LAS float* wsd = dts + 256; LAS float* misc = dts + 384;
        {   u32x4 w0, w1;
            w0.x = (px[0] & 0xffffu) | (px[1] << 16); w0.y = (px[2] & 0xffffu) | (px[3] << 16); w0.z = (px[4] & 0xffffu) | (px[5] << 16); w0.w = (px[6] & 0xffffu) | (px[7] << 16);
            w1.x = (px[0] >> 16) | (px[1] & 0xffff0000u); w1.y = (px[2] >> 16) | (px[3] & 0xffff0000u); w1.z = (px[4] >> 16) | (px[5] & 0xffff0000u); w1.w = (px[6] >> 16) | (px[7] & 0xffff0000u);
            *(LAS u32x4*)(lds + OFF_XT + (2 * xp) * PIT + xseg * 16) = w0; *(LAS u32x4*)(lds + OFF_XT + (2 * xp + 1) * PIT + xseg * 16) = w1; }
        {
#pragma unroll
            for (int i = 0; i < 16; ++i) *(LAS unsigned*)(lds + OFF_B + (bseg * 16 + i) * PIT + bp * 4) = pbv[i];
            float wv[16];
#pragma unroll
            for (int i = 0; i < 4; ++i) { const f32x4 t = *(const LAS f32x4*)(wsd + bseg * 16 + 4 * i); wv[4 * i] = t.x; wv[4 * i + 1] = t.y; wv[4 * i + 2] = t.z; wv[4 * i + 3] = t.w; }
#pragma unroll
            for (int hh = 0; hh < 2; ++hh) { u32x4 wa, wb;
#pragma unroll
                for (int j = 0; j < 4; ++j) { const int i0 = 8 * hh + 2 * j, i1 = i0 + 1;
                    wa[j] = cvt_pk_bf16(bf_lo(pbv[i0]) * wv[i0], bf_lo(pbv[i1]) * wv[i1]); wb[j] = cvt_pk_bf16(bf_hi(pbv[i0]) * wv[i0], bf_hi(pbv[i1]) * wv[i1]); }
                *(LAS u32x4*)(lds + OFF_BT + (2 * bp) * PIT + bseg * 32 + hh * 16) = wa; *(LAS u32x4*)(lds + OFF_BT + (2 * bp + 1) * PIT + bseg * 32 + hh * 16) = wb; }
        }
#pragma unroll
        for (int i = 0; i < 4; ++i) *(LAS u32x4*)(lds + OFF_C + (ct + 32 * i) * PIT + cg8 * 16) = pc[i];
        LBAR();
        u32x2 zq[4];
#pragma unroll
        for (int pt = 0; pt < 4; ++pt) zq[pt] = *(const u32x2*)(PROJ + (rowb + l0 + r) * NPROJ + C_Z + head * 64 + 16 * pt + 4 * q);
        if (c + 1 < SEQ / 128) SSD_ISSUE(c + 1);
        bf16x8 cf[4];
#pragma unroll
        for (int kk = 0; kk < 4; ++kk) cf[kk] = *(const LAS bf16x8*)(lds + OFF_C + (l0 + r) * PIT + kk * 64 + q * 16);
        f32x4 gacc[8];
#pragma unroll
        for (int st = 0; st < 8; ++st) { gacc[st] = (f32x4){0.f, 0.f, 0.f, 0.f};
            if (st <= lt) {
#pragma unroll
                for (int kk = 0; kk < 4; ++kk) { const bf16x8 bf = *(const LAS bf16x8*)(lds + OFF_B + (16 * st + r) * PIT + kk * 64 + q * 16); gacc[st] = MFMA16(bf, cf[kk], gacc[st]); } } }
        LBAR();
        const float acl = acs[l0 + r];
#pragma unroll
        for (int st = 0; st < 8; ++st) {
            if (st <= (lt | 1)) { const int s0 = 16 * st + 4 * q; const f32x4 as = *(const LAS f32x4*)(acs + s0), ds = *(const LAS f32x4*)(dts + s0); float mv[4];
#pragma unroll
                for (int j = 0; j < 4; ++j) { const bool ok = (st <= lt) && (l0 + r >= s0 + j); mv[j] = ok ? gacc[st][j] * __expf(acl - as[j]) * ds[j] : 0.f; }
                u32x2 w; w.x = cvt_pk_bf16(mv[0], mv[1]); w.y = cvt_pk_bf16(mv[2], mv[3]);
                *(LAS u32x2*)(lds + OFF_B + (l0 + r) * PIT + s0 * 2) = w; } }
        LBAR();
        f32x4 yd[4], yo[4];
#pragma unroll
        for (int i = 0; i < 4; ++i) { yd[i] = (f32x4){0.f, 0.f, 0.f, 0.f}; yo[i] = (f32x4){0.f, 0.f, 0.f, 0.f}; }
        const int kmax = lt >> 1;
#pragma unroll
        for (int kk = 0; kk < 4; ++kk) {
            if (kk <= kmax) { const bf16x8 mf = *(const LAS bf16x8*)(lds + OFF_B + (l0 + r) * PIT + kk * 64 + q * 16);
#pragma unroll
                for (int pt = 0; pt < 4; ++pt) { const bf16x8 xf = *(const LAS bf16x8*)(lds + OFF_XT + (16 * pt + r) * PIT + kk * 64 + q * 16); yd[pt] = MFMA16(xf, mf, yd[pt]); } }
#pragma unroll
            for (int pt = 0; pt < 4; ++pt) { const bf16x8 hf = *(const LAS bf16x8*)(lds + OFF_H + (16 * pt + r) * PIT + kk * 64 + q * 16); yo[pt] = MFMA16(hf, cf[kk], yo[pt]); }
        }
        { const float eend = misc[0];
#pragma unroll
          for (int pt = 0; pt < 4; ++pt) hacc[pt] *= eend;
#pragma unroll
          for (int kk = 0; kk < 4; ++kk) { const bf16x8 btf = *(const LAS bf16x8*)(lds + OFF_BT + (16 * wid + r) * PIT + kk * 64 + q * 16);
#pragma unroll
              for (int pt = 0; pt < 4; ++pt) { const bf16x8 xf = *(const LAS bf16x8*)(lds + OFF_XT + (16 * pt + r) * PIT + kk * 64 + q * 16); hacc[pt] = MFMA16(btf, xf, hacc[pt]); } } }
        { const float el = __expf(acl); const size_t row = rowb + l0 + r; float ss = 0.f;
#pragma unroll
          for (int pt = 0; pt < 4; ++pt) { const int p0 = 16 * pt + 4 * q; const u32x2 z2 = zq[pt]; float y[4];
#pragma unroll
              for (int j = 0; j < 4; ++j) { const float xv = bf2f(*(const LAS bf16_t*)(lds + OFF_XT + (p0 + j) * PIT + (l0 + r) * 2));
                  const unsigned zw = (j < 2) ? z2.x : z2.y; const float zv = (j & 1) ? bf_hi(zw) : bf_lo(zw);
                  y[j] = (yd[pt][j] + el * yo[pt][j] + Dh * xv) * silu_f(zv); ss += y[j] * y[j]; }
              u32x2 w; w.x = cvt_pk_bf16(y[0], y[1]); w.y = cvt_pk_bf16(y[2], y[3]);
              *(u32x2*)(YCAT + row * KCAT + head * 64 + p0) = w; }
          ss += __shfl_xor(ss, 16); ss += __shfl_xor(ss, 32);
          if (q == 0) atomicAdd(SSQ + row * 2 + g, ss * ssq_scale); }
        if (wid == 0 && c + 1 < SEQ / 128) SSD_SCAN(c + 1);
        LBAR();
#pragma unroll
        for (int pt = 0; pt < 4; ++pt) { u32x2 w; w.x = cvt_pk_bf16(hacc[pt][0], hacc[pt][1]); w.y = cvt_pk_bf16(hacc[pt][2], hacc[pt][3]);
            *(LAS u32x2*)(lds + OFF_H + (16 * pt + r) * PIT + (16 * wid + 4 * q) * 2) = w; }
    }
#undef SSD_ISSUE
#undef SSD_SCAN
    float* so = p.out + O_SSMP + ((size_t)(b * NH + head) * HD) * DS;
#pragma unroll
    for (int pt = 0; pt < 4; ++pt) *(f32x4*)(so + (size_t)(16 * pt + r) * DS + 16 * wid + 4 * q) = hacc[pt];
}

template <int W> __device__ __forceinline__ void pool_build(const Params& p, LAS unsigned char* lds, int row0, int k) {
    int tid_ = threadIdx.x; asm volatile("" : "+v"(tid_));
    const int tid = tid_, cp = tid & 63, ts0 = (tid >> 6) * 16;
    const bf16_t* PROJ = (const bf16_t*)(p.ws + WS_PROJ);
    const bf16_t* ucol = PROJ + C_U + k * 128 + 2 * cp;
    constexpr float invW = 1.f / (float)W;
    if (row0 < NTOK_P) {
        const int tb = (row0 & (SEQ - 1)) + ts0; const size_t rw = (size_t)row0 + ts0;
        unsigned raw[W - 1 + 16];
#pragma unroll
        for (int i = 0; i < W - 1 + 16; ++i) raw[i] = (tb + i - (W - 1)) >= 0 ? *(const unsigned*)(ucol + (rw + i - (W - 1)) * NPROJ) : 0u;
        float r0 = 0.f, r1 = 0.f;
#pragma unroll
        for (int i = 0; i < W - 1; ++i) { r0 += bf_lo(raw[i]); r1 += bf_hi(raw[i]); }
#pragma unroll
        for (int i = 0; i < 16; ++i) { const float c0 = bf_lo(raw[i + W - 1]), c1 = bf_hi(raw[i + W - 1]); r0 += c0; r1 += c1;
            const int cnt = min(tb + i + 1, W); const float ic = cnt == W ? invW : __builtin_amdgcn_rcpf((float)cnt);
            *(LAS unsigned*)(lds + (ts0 + i) * PIT + cp * 4) = cvt_pk_bf16(r0 * ic - c0, r1 * ic - c1);
            r0 -= bf_lo(raw[i]); r1 -= bf_hi(raw[i]); }
    } else {
#pragma unroll
        for (int hb = 0; hb < 2; ++hb) { const int row = row0 + ts0 + 8 * hb, bb = (row - NTOK_P) >> 3;
            float e0[W - 1 + 8], e1[W - 1 + 8];
#pragma unroll
            for (int i = 0; i < W - 1; ++i) { const f32x2 sv = *(const f32x2*)(p.st_pool + ((size_t)bb * 15 + 15 - (W - 1) + i) * DPOOL + k * 128 + 2 * cp); e0[i] = sv.x; e1[i] = sv.y; }
#pragma unroll
            for (int i = 0; i < 8; ++i) { const unsigned u = *(const unsigned*)(ucol + (size_t)(row + i) * NPROJ); e0[W - 1 + i] = bf_lo(u); e1[W - 1 + i] = bf_hi(u); }
            float r0 = 0.f, r1 = 0.f;
#pragma unroll
            for (int i = 0; i < W - 1; ++i) { r0 += e0[i]; r1 += e1[i]; }
#pragma unroll
            for (int i = 0; i < 8; ++i) { const float c0 = e0[W - 1 + i], c1 = e1[W - 1 + i]; r0 += c0; r1 += c1;
                *(LAS unsigned*)(lds + (ts0 + 8 * hb + i) * PIT + cp * 4) = cvt_pk_bf16(r0 * invW - c0, r1 * invW - c1);
                r0 -= e0[i]; r1 -= e1[i]; } }
    }
}
__device__ __forceinline__ void pool_item(const Params& p, LAS unsigned char* lds, int j) {
    int tid_ = threadIdx.x; asm volatile("" : "+v"(tid_));
    const int tid = tid_, wid = __builtin_amdgcn_readfirstlane(tid >> 6), lane = tid & 63, r = lane & 15, q = lane >> 4;
    const bf16_t* PROJ = (const bf16_t*)(p.ws + WS_PROJ); const bf16_t* PMIX = (const bf16_t*)(p.ws + WS_PMIX); bf16_t* YCAT = (bf16_t*)(p.out + O_YP);
    const int row0 = 128 * j;
    for (int k = 0; k < 4; ++k) {
        bf16x8 mf[4];
#pragma unroll
        for (int kk = 0; kk < 4; ++kk) mf[kk] = *(const bf16x8*)(PMIX + ((size_t)k * 128 + 16 * wid + r) * 128 + kk * 32 + q * 8);
        const int d0 = k * 128 + 16 * wid + 4 * q; const f32x4 sc = *(const f32x4*)(p.pool_scale + d0);
        u32x2 g2[8];
#pragma unroll
        for (int tt = 0; tt < 8; ++tt) g2[tt] = *(const u32x2*)(PROJ + ((size_t)row0 + 16 * tt + r) * NPROJ + C_G + d0);
        if (k == 0) pool_build<2>(p, lds, row0, 0); else if (k == 1) pool_build<4>(p, lds, row0, 1); else if (k == 2) pool_build<8>(p, lds, row0, 2); else pool_build<16>(p, lds, row0, 3);
        LBAR();
#pragma unroll
        for (int tt = 0; tt < 8; ++tt) { f32x4 acc = (f32x4){0.f, 0.f, 0.f, 0.f};
#pragma unroll
            for (int kk = 0; kk < 4; ++kk) { const bf16x8 af = *(const LAS bf16x8*)(lds + (16 * tt + r) * PIT + kk * 64 + q * 16); acc = MFMA16(mf[kk], af, acc); }
            const size_t row = (size_t)row0 + 16 * tt + r;
            const float y0 = acc[0] * sc.x * silu_f(bf_lo(g2[tt].x)), y1 = acc[1] * sc.y * silu_f(bf_hi(g2[tt].x)), y2 = acc[2] * sc.z * silu_f(bf_lo(g2[tt].y)), y3 = acc[3] * sc.w * silu_f(bf_hi(g2[tt].y));
            u32x2 w; w.x = cvt_pk_bf16(y0, y1); w.y = cvt_pk_bf16(y2, y3);
            *(u32x2*)(YCAT + row * KCAT + 1024 + d0) = w; }
        LBAR();
    }
}

constexpr int SMP_LDS = 10752;
__device__ __forceinline__ void ssd_sample_wave(const Params& p, LAS unsigned char* lds, int it, float ssq_scale) {
    int tid_ = threadIdx.x; asm volatile("" : "+v"(tid_));
    const int tid = tid_, wid = __builtin_amdgcn_readfirstlane(tid >> 6), lane = tid & 63, r = lane & 15, q = lane >> 4;
    const int b = it >> 4, head = it & 15, g = head >> 3;
    const bf16_t* PROJ = (const bf16_t*)(p.ws + WS_PROJ); const bf16_t* ACT = (const bf16_t*)(p.ws + WS_X); const float* DT = (const float*)(p.ws + WS_DT); float* SSQ = (float*)(p.ws + WS_SSQ); bf16_t* YCAT = (bf16_t*)(p.out + O_YP);
    LAS float* xs = (LAS float*)(lds + wid * SMP_LDS); LAS float* Bs = xs + 512; LAS float* Cs = Bs + 1024; LAS float* Ms = Cs + 1024;
    const size_t row0 = (size_t)NTOK_P + (size_t)b * LS;
    const float* hin = p.st_ssm + ((size_t)(b * NH + head) * HD) * DS; float* hout = p.out + O_SSMS + ((size_t)(b * NH + head) * HD) * DS;
    f32x4 hq[3][4];
#pragma unroll
    for (int d = 0; d < 3; ++d)
#pragma unroll
        for (int pt = 0; pt < 4; ++pt) hq[d][pt] = *(const f32x4*)(hin + (size_t)(16 * pt + r) * DS + 16 * d + 4 * q);
    bf16_t zr[2][4];
#pragma unroll
    for (int e = 0; e < 2; ++e)
#pragma unroll
        for (int pt = 0; pt < 4; ++pt) zr[e][pt] = PROJ[(row0 + 2 * q + e) * NPROJ + C_Z + head * 64 + 16 * pt + r];
    {   const int t = lane >> 3, gi = lane & 7; const bf16_t* arow = ACT + (row0 + t) * KCAT;
        const u32x4 xv = *(const u32x4*)(arow + head * 64 + 8 * gi), b0 = *(const u32x4*)(arow + 1024 + g * 128 + 8 * gi), b1 = *(const u32x4*)(arow + 1024 + g * 128 + 64 + 8 * gi),
                    c0 = *(const u32x4*)(arow + 1280 + g * 128 + 8 * gi), c1 = *(const u32x4*)(arow + 1280 + g * 128 + 64 + 8 * gi);
#define SMP_PUT(dst, v) do { *(LAS f32x4*)(dst) = (f32x4){bf_lo((v).x), bf_hi((v).x), bf_lo((v).y), bf_hi((v).y)}; *(LAS f32x4*)((dst) + 4) = (f32x4){bf_lo((v).z), bf_hi((v).z), bf_lo((v).w), bf_hi((v).w)}; } while (0)
        SMP_PUT(xs + t * 64 + 8 * gi, xv); SMP_PUT(Bs + t * 128 + 8 * gi, b0); SMP_PUT(Bs + t * 128 + 64 + 8 * gi, b1); SMP_PUT(Cs + t * 128 + 8 * gi, c0); SMP_PUT(Cs + t * 128 + 64 + 8 * gi, c1);
#undef SMP_PUT
    }
    const float a_h = -__expf(p.a_log[head]), Dh = p.d_skip[head];
    const float dtl = DT[(row0 + (lane & 7)) * 16 + head];
    float acl = dtl * a_h;
#pragma unroll
    for (int o = 1; o < 8; o <<= 1) { const float t = __shfl_up(acl, o, 8); if ((lane & 7) >= o) acl += t; }
    const float ac7 = __shfl(acl, 7, 8);
    LDS_WAIT();
    {
        const int l = lane >> 3, s = lane & 7; float acc = 0.f;
#pragma unroll 8
        for (int n = 0; n < 128; n += 4) { const f32x4 cv = *(const LAS f32x4*)(Cs + l * 128 + n), bv = *(const LAS f32x4*)(Bs + s * 128 + n); acc += (cv.x * bv.x + cv.y * bv.y) + (cv.z * bv.z + cv.w * bv.w); }
        const float al = __shfl(acl, l);
        Ms[lane] = s <= l ? acc * __expf(al - acl) * dtl : 0.f;
    }
    float xw[4][8];
    const float wl = dtl * __expf(ac7 - acl);
#pragma unroll
    for (int s = 0; s < 8; ++s) { const float ws_ = __shfl(wl, s);
#pragma unroll
        for (int pt = 0; pt < 4; ++pt) xw[pt][s] = xs[s * 64 + 16 * pt + r] * ws_; }
    const float eend = __expf(ac7);
    float yo[4][8];
#pragma unroll
    for (int pt = 0; pt < 4; ++pt)
#pragma unroll
        for (int l = 0; l < 8; ++l) yo[pt][l] = 0.f;
#pragma unroll
    for (int nt = 0; nt < 8; ++nt) {
        f32x4 h[4];
#pragma unroll
        for (int pt = 0; pt < 4; ++pt) h[pt] = hq[nt % 3][pt];
        if (nt + 3 < 8) {
#pragma unroll
            for (int pt = 0; pt < 4; ++pt) hq[nt % 3][pt] = *(const f32x4*)(hin + (size_t)(16 * pt + r) * DS + 16 * (nt + 3) + 4 * q); }
        const int n4 = 16 * nt + 4 * q;
#pragma unroll
        for (int l = 0; l < 8; ++l) { const f32x4 cv = *(const LAS f32x4*)(Cs + l * 128 + n4);
#pragma unroll
            for (int pt = 0; pt < 4; ++pt) yo[pt][l] += (cv.x * h[pt].x + cv.y * h[pt].y) + (cv.z * h[pt].z + cv.w * h[pt].w); }
#pragma unroll
        for (int pt = 0; pt < 4; ++pt) h[pt] *= eend;
#pragma unroll
        for (int s = 0; s < 8; ++s) { const f32x4 bv = *(const LAS f32x4*)(Bs + s * 128 + n4);
#pragma unroll
            for (int pt = 0; pt < 4; ++pt) h[pt] += bv * xw[pt][s]; }
#pragma unroll
        for (int pt = 0; pt < 4; ++pt) *(f32x4*)(hout + (size_t)(16 * pt + r) * DS + n4) = h[pt];
    }
#pragma unroll
    for (int pt = 0; pt < 4; ++pt)
#pragma unroll
        for (int l = 0; l < 8; ++l) { float v = yo[pt][l]; v += __shfl_xor(v, 16); v += __shfl_xor(v, 32); yo[pt][l] = v; }
    LDS_WAIT();
#pragma unroll
    for (int e = 0; e < 2; ++e) { const int l = 2 * q + e; const float al = __shfl(acl, l), el = __expf(al); float ss = 0.f;
#pragma unroll
        for (int pt = 0; pt < 4; ++pt) { const int pp = 16 * pt + r;
            const float yoff = e == 0 ? (q == 0 ? yo[pt][0] : q == 1 ? yo[pt][2] : q == 2 ? yo[pt][4] : yo[pt][6]) : (q == 0 ? yo[pt][1] : q == 1 ? yo[pt][3] : q == 2 ? yo[pt][5] : yo[pt][7]);
            float y = el * yoff;
            for (int s = 0; s <= l; ++s) y += Ms[l * 8 + s] * xs[s * 64 + pp];
            y += Dh * xs[l * 64 + pp];
            y *= silu_f(bf2f(zr[e][pt]));
            ss += y * y;
            YCAT[(row0 + l) * KCAT + head * 64 + pp] = (bf16_t)(cvt_pk_bf16(y, 0.f) & 0xffffu); }
        ss += __shfl_xor(ss, 1); ss += __shfl_xor(ss, 2); ss += __shfl_xor(ss, 4); ss += __shfl_xor(ss, 8);
        if (r == 0) atomicAdd(SSQ + (row0 + l) * 2 + g, ss * ssq_scale); }
    LDS_WAIT();
}

constexpr int R_CP = NB_P * 3, R_PP = NB_P * 15, R_CS = NB_S * 3, R_PS = NB_S * 15, R_ALL = R_CP + R_PP + R_CS + R_PS, N_COPY = 72, R_PER = R_ALL / N_COPY;
static_assert(R_ALL % N_COPY == 0 && R_PER % 2 == 0, "copy split");
__device__ __forceinline__ void copy_item(const Params& p, int it) {
    const bf16_t* PROJ = (const bf16_t*)(p.ws + WS_PROJ);
    int tid_ = threadIdx.x; asm volatile("" : "+v"(tid_));
    const int wave = tid_ >> 6, lane = tid_ & 63;
    for (int rr = it * R_PER + wave; rr < (it + 1) * R_PER; rr += 8) {
        int r = rr; const bf16_t* src = nullptr; const float* fsrc = nullptr; float* dst; int nch;
        if (r < R_CP) { const int b = r / 3, j = r % 3; src = PROJ + ((size_t)b * SEQ + SEQ - 3 + j) * NPROJ + C_XBC; dst = p.out + O_CONVP + (size_t)r * CONVD; nch = CONVD; }
        else if ((r -= R_CP) < R_PP) { const int b = r / 15, j = r % 15; src = PROJ + ((size_t)b * SEQ + SEQ - 15 + j) * NPROJ + C_U; dst = p.out + O_POOLP + (size_t)r * DPOOL; nch = DPOOL; }
        else if ((r -= R_PP) < R_CS) { const int b = r / 3, j = r % 3; src = PROJ + ((size_t)NTOK_P + b * LS + LS - 3 + j) * NPROJ + C_XBC; dst = p.out + O_CONVS + (size_t)r * CONVD; nch = CONVD; }
        else { r -= R_CS; const int b = r / 15, j = r % 15; dst = p.out + O_POOLS + (size_t)r * DPOOL; nch = DPOOL;
            if (j < 7) fsrc = p.st_pool + ((size_t)b * 15 + 8 + j) * DPOOL; else src = PROJ + ((size_t)NTOK_P + b * LS + (j - 7)) * NPROJ + C_U; }
        for (int c = 8 * lane; c < nch; c += 512) {
            if (src) { const u32x4 v = *(const u32x4*)(src + c);
                *(f32x4*)(dst + c) = (f32x4){bf_lo(v.x), bf_hi(v.x), bf_lo(v.y), bf_hi(v.y)}; *(f32x4*)(dst + c + 4) = (f32x4){bf_lo(v.z), bf_hi(v.z), bf_lo(v.w), bf_hi(v.w)}; }
            else { *(f32x4*)(dst + c) = *(const f32x4*)(fsrc + c); *(f32x4*)(dst + c + 4) = *(const f32x4*)(fsrc + c + 4); } }
    }
}

constexpr int IT_SSD = NB_P * NH, IT_POOL = MTOK / 128, IT_SMP = NB_S * NH / 8, IT_ALL = IT_SSD + IT_POOL + IT_SMP + N_COPY;
__device__ __forceinline__ void phase2(const Params& p, LAS unsigned char* lds, float ssq_scale) {
    unsigned* ctr = (unsigned*)(p.ws + WS_CTL);
    volatile LAS int* slot = (volatile LAS int*)(lds + OFF_MISC);
    for (;;) {
        __syncthreads();
        if (threadIdx.x == 0) slot[0] = (int)atomicAdd(ctr, 1u);
        __syncthreads();
        const int it = slot[0];
        if (it >= IT_ALL) break;
        const int nrep_ssd = 1 + ((REP_PHASE == 30) ? (int)(p.ph_lo == 0) : 0), nrep_oth = 1 + ((REP_PHASE == 31) ? (int)(p.ph_lo == 0) : 0);
        if (it < IT_SSD) { for (int rep = 0; rep < nrep_ssd; ++rep) { ssd_prompt_item(p, lds, it, rep == nrep_ssd - 1 ? ssq_scale : 0.f); __syncthreads(); } }
        else for (int rep = 0; rep < nrep_oth; ++rep) {
            if (it < IT_SSD + IT_POOL) pool_item(p, lds, it - IT_SSD);
            else if (it < IT_SSD + IT_POOL + IT_SMP) ssd_sample_wave(p, lds, (it - IT_SSD - IT_POOL) * 8 + (int)(threadIdx.x >> 6), rep == nrep_oth - 1 ? ssq_scale : 0.f);
            else copy_item(p, it - IT_SSD - IT_POOL - IT_SMP);
            __syncthreads(); }
    }
}

template <int MODE  >
__device__ __forceinline__ void mini_gemm(const Params& p, float ssq_scale = 1.f) {
    int tid_ = threadIdx.x; asm volatile("" : "+v"(tid_));
    const int wave = tid_ >> 6, lane = tid_ & 63, r = lane & 15, q = lane >> 4;
    constexpr int K = MODE == 0 ? KCAT : DM;
    const bf16_t* A = MODE == 0 ? (const bf16_t*)(p.out + O_YP) : (const bf16_t*)(p.ws + WS_MERGED);
    const bf16_t* B = MODE == 0 ? (const bf16_t*)(p.ws + WS_WCAT) : (const bf16_t*)(p.ws + WS_WOUT);
    const bf16_t* PROJ = (const bf16_t*)(p.ws + WS_PROJ); const float* SSQ = (const float*)(p.ws + WS_SSQ); float* SSQ2 = (float*)(p.ws + WS_SSQ2);
    bf16_t* O = MODE == 0 ? (bf16_t*)(p.ws + WS_MERGED) : (bf16_t*)(p.ws + WS_PROJ);
    for (int tile = blockIdx.x; tile < 256; tile += gridDim.x) {
        const int tm = tile >> 4, tn = tile & 15;
        const int row = NTOK_P + tm * 64 + (wave >> 1) * 16 + r, n0 = tn * 64 + (wave & 1) * 32;
        const bf16_t* ap = A + (size_t)row * K + 8 * q; const bf16_t* bp0 = B + (size_t)(n0 + r) * K + 8 * q; const bf16_t* bp1 = bp0 + (size_t)16 * K;
        f32x4 acc0 = (f32x4){0.f, 0.f, 0.f, 0.f}, acc1 = (f32x4){0.f, 0.f, 0.f, 0.f};
#pragma unroll 1
        for (int seg = 0; seg < K / 512; ++seg) {
#pragma unroll 8
            for (int ks = 0; ks < 16; ++ks) { const int k0 = seg * 512 + ks * 32;
                const bf16x8 a = *(const bf16x8*)(ap + k0), b0 = *(const bf16x8*)(bp0 + k0), b1 = *(const bf16x8*)(bp1 + k0);
                acc0 = MFMA16(b0, a, acc0); acc1 = MFMA16(b1, a, acc1); }
            if (MODE == 0) {
                const f32x2 s = *(const f32x2*)(SSQ + 2 * (size_t)row); const float q1 = s.y * (1.f / 512.f) + EPS, r1 = rsqrtf(q1), rr = rsqrtf(s.x * (1.f / 512.f) + EPS) * __builtin_amdgcn_sqrtf(q1);
                if (seg == 0) { acc0 *= rr; acc1 *= rr; }
                else { const bf16_t* gp = PROJ + (size_t)row * NPROJ + C_GATE + (seg == 2 ? 1024 : 0) + n0 + 4 * q; const u32x2 f0 = *(const u32x2*)gp, f1 = *(const u32x2*)(gp + 16);
                    const float rowf = seg == 1 ? r1 : 1.f;
                    acc0 *= (f32x4){bf_lo(f0.x), bf_hi(f0.x), bf_lo(f0.y), bf_hi(f0.y)} * rowf; acc1 *= (f32x4){bf_lo(f1.x), bf_hi(f1.x), bf_lo(f1.y), bf_hi(f1.y)} * rowf; }
            }
        }
        u32x2 w0, w1; w0.x = cvt_pk_bf16(acc0[0], acc0[1]); w0.y = cvt_pk_bf16(acc0[2], acc0[3]); w1.x = cvt_pk_bf16(acc1[0], acc1[1]); w1.y = cvt_pk_bf16(acc1[2], acc1[3]);
        *(u32x2*)(O + (size_t)row * DM + n0 + 4 * q) = w0; *(u32x2*)(O + (size_t)row * DM + n0 + 16 + 4 * q) = w1;
        if (MODE == 1) { float ss = (acc0[0] * acc0[0] + acc0[1] * acc0[1]) + (acc0[2] * acc0[2] + acc0[3] * acc0[3]) + (acc1[0] * acc1[0] + acc1[1] * acc1[1]) + (acc1[2] * acc1[2] + acc1[3] * acc1[3]);
            ss += __shfl_xor(ss, 16); ss += __shfl_xor(ss, 32);
            if (q == 0) atomicAdd(SSQ2 + row, ss * ssq_scale); }
    }
}

__device__ __forceinline__ void phase5(const Params& p) {
    const int tid = threadIdx.x, lane = tid & 63, wave = tid >> 6; const int gw = blockIdx.x * 8 + wave, NGW = gridDim.x * 8;
    const bf16_t* OUTB = (const bf16_t*)(p.ws + WS_PROJ); const float* SSQ2 = (const float*)(p.ws + WS_SSQ2);
    for (int m = gw; m < MTOK; m += NGW) {
        const float* xrow = m < NTOK_P ? p.x_p + (size_t)m * DM : p.x_s + (size_t)(m - NTOK_P) * DM;
        float* yrow = m < NTOK_P ? p.out + O_YP + (size_t)m * DM : p.out + O_YS + (size_t)(m - NTOK_P) * DM;
        const float rstd = rsqrtf(SSQ2[m] * (1.f / DM) + EPS);
#pragma unroll
        for (int j = 0; j < 4; ++j) { const f32x4 x4 = ((const f32x4*)xrow)[lane + 64 * j], g4 = ((const f32x4*)p.norm_post)[lane + 64 * j]; const u32x2 o2 = ((const u32x2*)(OUTB + (size_t)m * DM))[lane + 64 * j];
            f32x4 y; y.x = x4.x + bf_lo(o2.x) * rstd * g4.x; y.y = x4.y + bf_hi(o2.x) * rstd * g4.y; y.z = x4.z + bf_lo(o2.y) * rstd * g4.z; y.w = x4.w + bf_hi(o2.y) * rstd * g4.w;
            ((f32x4*)yrow)[lane + 64 * j] = y; }
    }
}

#include <cstdlib>
#include <vector>

#define XB_TMO      128
#define XB_XCNT(j)  (256  + 64 * (j))
#define XB_XSUB(j)  (1280 + 64 * (j))
#define XB_XGEN(j)  (2304 + 64 * (j))
#define XB_TOP      3328
#define XB_TOPGEN   3392
#define XCD_BAR_WORDS 3456
#define XB_SPIN_CAP (1u << 18)

__device__ __forceinline__ unsigned xb_ld(unsigned* p)              { return __hip_atomic_load(p, __ATOMIC_RELAXED, __HIP_MEMORY_SCOPE_AGENT); }
__device__ __forceinline__ unsigned xb_add(unsigned* p, unsigned v) { return __hip_atomic_fetch_add(p, v, __ATOMIC_RELAXED, __HIP_MEMORY_SCOPE_AGENT); }
__device__ __forceinline__ unsigned xb_xcc_id() { return (unsigned)__builtin_amdgcn_s_getreg((3 << 11) | 20) & 0xFu; }
#define XB_SPIN(cond, bar) do { unsigned _sp = 0; while (cond) { __builtin_amdgcn_s_sleep(1); \
    if ((++_sp & 255u) == 0u) { if (xb_ld(&(bar)[XB_TMO])) break; if (_sp > XB_SPIN_CAP) { atomicAdd(&(bar)[XB_TMO], 1u); break; } } } } while (0)

struct XcdBarrier {
    unsigned* bar; unsigned x;
    volatile LAS unsigned* st;
};

__device__ __forceinline__ XcdBarrier xcd_barrier_post(unsigned* bar, volatile LAS unsigned* st) {
    XcdBarrier b; b.bar = bar; b.x = xb_xcc_id(); b.st = st;
    if (threadIdx.x == 0) (void)xb_add(&bar[XB_XCNT(b.x)], 1u);
    return b;
}
__device__ __forceinline__ void xcd_barrier_complete(unsigned* bar, unsigned x, unsigned& nloc, unsigned& nx) {
    const unsigned G = gridDim.x * gridDim.y * gridDim.z;
    unsigned sum, cnt, mine, sp = 0u;
    for (;;) {
        sum = 0u; cnt = 0u; mine = 0u;
#pragma unroll
        for (unsigned j = 0; j < 16; ++j) { const unsigned c = xb_ld(&bar[XB_XCNT(j)]); sum += c; cnt += (c > 0u) ? 1u : 0u; mine = (j == x) ? c : mine; }
        if (sum == G) break;
        __builtin_amdgcn_s_sleep(1);
        if ((++sp & 255u) == 0u) { if (xb_ld(&bar[XB_TMO])) break; if (sp > XB_SPIN_CAP) { atomicAdd(&bar[XB_TMO], 1u); break; } }
    }
    nloc = mine > 0u ? mine : 1u; nx = cnt > 0u ? cnt : 1u;
}

__device__ __forceinline__ void xcd_barrier(const XcdBarrier& b) {
    asm volatile("s_waitcnt vmcnt(0)" ::: "memory");
    __syncthreads();
    if (threadIdx.x == 0) {
        unsigned* bar = b.bar;
        __builtin_amdgcn_s_waitcnt(0);
        unsigned nloc = b.st[0], nx = b.st[1];
        if (nloc == 0u) { xcd_barrier_complete(bar, b.x, nloc, nx); b.st[0] = nloc; b.st[1] = nx; }
        const unsigned old = xb_add(&bar[XB_XSUB(b.x)], 1u);
        const unsigned gen = old / nloc;
        if (old + 1u == (gen + 1u) * nloc) {
            __builtin_amdgcn_fence(__ATOMIC_RELEASE, "agent");
            asm volatile("s_waitcnt vmcnt(0)" ::: "memory");
            const unsigned og = xb_add(&bar[XB_TOP], 1u);
            const unsigned tg = og / nx;
            if (og + 1u == (tg + 1u) * nx) xb_add(&bar[XB_TOPGEN], 1u);
            else XB_SPIN(xb_ld(&bar[XB_TOPGEN]) == tg, bar);
            __builtin_amdgcn_fence(__ATOMIC_ACQUIRE, "agent");
            xb_add(&bar[XB_XGEN(b.x)], 1u);
            asm volatile("s_waitcnt vmcnt(0)" ::: "memory");
        } else {
            XB_SPIN(xb_ld(&bar[XB_XGEN(b.x)]) == gen, bar);
            __builtin_amdgcn_fence(__ATOMIC_ACQUIRE, "agent");
            asm volatile("s_waitcnt vmcnt(0)" ::: "memory");
        }
    }
    __syncthreads();
}


__global__ void __launch_bounds__(512, 2) fwd_kernel(Params p) {
    extern __shared__ __attribute__((aligned(16))) unsigned char smem[];
    LAS unsigned char* lds = (LAS unsigned char*)smem;
    cg::grid_group grid = cg::this_grid();
    unsigned char* ws = p.ws;
    const int lo = p.ph_lo, hi = p.ph_hi;
#define IN(k) (lo <= (k) && (k) < hi)
    XcdBarrier xbar; xbar.bar = (unsigned*)(ws + WS_BAR); xbar.x = 0; xbar.st = (volatile LAS unsigned*)(lds + OFF_MISC + 16);
    const bool multi = hi - lo > 1;
    if (multi) {
        if (threadIdx.x == 0) { xbar.st[0] = 0u; xbar.st[1] = 0u; }
        __syncthreads();
        if (lo < 0) grid.sync();
        xbar = xcd_barrier_post((unsigned*)(ws + WS_BAR), (volatile LAS unsigned*)(lds + OFF_MISC + 16));
    }
#define SEAM(k) do { if (IN(k) && IN((k) + 1)) xcd_barrier(xbar); } while (0)
    if (IN(0)) for (int rep = 0; rep < (REP_PHASE == 0 ? 2 : 1); ++rep) phase0(p, lds);
    SEAM(0);
    if (IN(1)) for (int rep = 0; rep < (REP_PHASE == 1 ? 2 : 1); ++rep) { pg8::Gemm g{(const bf16_t*)(p.out + O_YP), (const bf16_t*)(ws + WS_WIN), MTOK, NPROJ, DM}; pg8::StaticOrder S; S.init(MTOK, NPROJ, (int)gridDim.x, (int)blockIdx.x);
        pg8::EpiStore E{(bf16_t*)(ws + WS_PROJ), NPROJ}; pg8::gemm_phase<pg8::EpiStore, pg8::StaticOrder>(lds, g, S, E); }
    SEAM(1);
    if (IN(2)) for (int rep = 0; rep < (REP_PHASE == 2 ? 2 : 1); ++rep) phase_conv(p);
    SEAM(2);
    if (IN(3)) {
        if (REP_PHASE == 3) { phase2(p, lds, 0.f); xcd_barrier(xbar); if (blockIdx.x == 0 && threadIdx.x == 0) *(unsigned*)(ws + WS_CTL) = 0u; xcd_barrier(xbar); }
        phase2(p, lds, 1.f); }
    SEAM(3);
    if (IN(4)) for (int rep = 0; rep < (REP_PHASE == 4 ? 2 : 1); ++rep) { pg8::Gemm g{(const bf16_t*)(p.out + O_YP), (const bf16_t*)(ws + WS_WCAT), NTOK_P, DM, KCAT}; pg8::SegOrder S; S.init(NTOK_P, DM, (int)gridDim.x, (int)blockIdx.x);
        pg8::EpiMerge E{(const bf16_t*)(ws + WS_PROJ), (const float*)(ws + WS_SSQ), (bf16_t*)(ws + WS_MERGED)}; pg8::gemm_phase<pg8::EpiMerge, pg8::SegOrder>(lds, g, S, E);
        mini_gemm<0>(p); }
    SEAM(4);
    if (IN(5)) for (int rep = 0; rep < (REP_PHASE == 5 ? 2 : 1); ++rep) { pg8::Gemm g{(const bf16_t*)(ws + WS_MERGED), (const bf16_t*)(ws + WS_WOUT), NTOK_P, DM, DM}; pg8::StaticOrder S; S.init(NTOK_P, DM, (int)gridDim.x, (int)blockIdx.x);
        pg8::EpiOut E{(bf16_t*)(ws + WS_PROJ), (float*)(ws + WS_SSQ2), (REP_PHASE == 5 && rep == 0) ? 0.f : 1.f}; pg8::gemm_phase<pg8::EpiOut, pg8::StaticOrder>(lds, g, S, E);
        mini_gemm<1>(p, (REP_PHASE == 5 && rep == 0) ? 0.f : 1.f); }
    SEAM(5);
    if (IN(6)) for (int rep = 0; rep < (REP_PHASE == 6 ? 2 : 1); ++rep) phase5(p);
    if (REP_PHASE == 40) { for (int i = 0; i < 10; ++i) xcd_barrier(xbar); }
}

#ifndef N_LAUNCH_MODE
#define N_LAUNCH_MODE 1
#endif
extern "C" void kernel_launch(void* const* d_in, const int* in_sizes, int n_in, void* d_out, int out_size, void* d_ws, size_t ws_size, hipStream_t stream) {
    static int grid = 0;
    if (grid == 0) {
        if (n_in != 19 || (size_t)out_size != O_END || ws_size < WS_END) { fprintf(stderr, "kernel_launch: unexpected sizes n_in %d out %d ws %zu (need %zu)\n", n_in, out_size, ws_size, (size_t)WS_END); grid = -1; return; }
        int dev = 0, cus = 0, per_cu = 0;
        hipGetDevice(&dev); hipDeviceGetAttribute(&cus, hipDeviceAttributeMultiprocessorCount, dev);
        if (hipFuncSetAttribute((const void*)fwd_kernel, hipFuncAttributeMaxDynamicSharedMemorySize, LDS_BYTES) != hipSuccess) { fprintf(stderr, "kernel_launch: hipFuncSetAttribute failed\n"); grid = -1; return; }
        if (hipOccupancyMaxActiveBlocksPerMultiprocessor(&per_cu, (const void*)fwd_kernel, 512, LDS_BYTES) != hipSuccess || per_cu < 1) { fprintf(stderr, "kernel_launch: occupancy query failed (%d)\n", per_cu); grid = -1; return; }
        grid = cus;
    }
    if (grid <= 0) return;
    Params p{};
    const float** f = (const float**)&p;
    for (int i = 0; i < 19; ++i) f[i] = (const float*)d_in[i];
    p.out = (float*)d_out; p.ws = (unsigned char*)d_ws;
    if (N_LAUNCH_MODE == 1) {
        p.ph_lo = 0; p.ph_hi = 7; void* args[] = {&p};
        if (hipMemsetAsync((unsigned char*)d_ws + WS_BAR, 0, 16384, stream) != hipSuccess) { fprintf(stderr, "kernel_launch: memset of the barrier words failed\n"); return; }
        hipError_t e = hipLaunchCooperativeKernel((const void*)fwd_kernel, dim3(grid), dim3(512), args, LDS_BYTES, stream);
        if (e != hipSuccess) fprintf(stderr, "cooperative launch failed: %s (grid %d)\n", hipGetErrorString(e), grid);
    } else {
        for (int ph = 0; ph < 7; ++ph) { p.ph_lo = ph; p.ph_hi = ph + 1; hipLaunchKernelGGL(fwd_kernel, dim3(grid), dim3(512), LDS_BYTES, stream, p); }
    }
}
```
